# Optimizing an MI355X kernel written in HIP

```python
import jax, jax.numpy as jnp
from jax import lax
import numpy as np

D_MODEL = 1024
BATCH = 4
SEQ = 8192
DEPTH = 2

GROUP_WIDTH = D_MODEL // 4
MIX_WIDTH = 4 * GROUP_WIDTH
FOX_HEADS = 4
FOX_HEAD_DIM = GROUP_WIDTH // FOX_HEADS
Q_BLOCK = 128
GLA_HEADS = 4
GLA_DV = GROUP_WIDTH // GLA_HEADS
GLA_DK = GLA_DV // 2
GLA_GATE_RANK = 16
GLA_GATE_TAU = 16.0
GLA_CHUNK = 64
MLA_HEADS = 4
MLA_NOPE_DIM = 64
MLA_ROPE_DIM = 32
MLA_V_DIM = GROUP_WIDTH // MLA_HEADS
MLA_Q_LORA = 256
MLA_KV_LORA = 128
ROPE_THETA = 10000.0
SSM_D_INNER = GROUP_WIDTH
SSM_HEAD_DIM = 64
SSM_HEADS = SSM_D_INNER // SSM_HEAD_DIM
SSM_GROUPS = 2
SSM_STATE = 128
SSM_CONV = 4
SSM_CHUNK = 128
SSM_CONV_DIM = SSM_D_INNER + 2 * SSM_GROUPS * SSM_STATE
FFN_HIDDEN = -(-8 * D_MODEL // (3 * 256)) * 256
EPS = 1e-6

IN_SPLITS = (
    FOX_HEADS * FOX_HEAD_DIM, FOX_HEADS * FOX_HEAD_DIM, FOX_HEADS * FOX_HEAD_DIM, FOX_HEADS,
    GLA_HEADS * GLA_DK, GLA_HEADS * GLA_DK, GLA_HEADS * GLA_DV, GLA_HEADS * GLA_DV, GLA_GATE_RANK,
    MLA_Q_LORA, MLA_KV_LORA, MLA_ROPE_DIM,
    SSM_D_INNER, SSM_CONV_DIM, SSM_HEADS,
)
IN_COLS = sum(IN_SPLITS)

kernel_name = "hybrid_fox_gla_mla_ssd_block"


def split_cols(t, sizes):
    out, off = [], 0
    for s in sizes:
        out.append(t[..., off:off + s])
        off += s
    return out


def rmsnorm(x, g):
    xf = x.astype(jnp.float32)
    y = xf * lax.rsqrt(jnp.mean(xf * xf, axis=-1, keepdims=True) + EPS)
    return (y * g.astype(jnp.float32)).astype(x.dtype)


def to_heads(t, h):
    b, s, _ = t.shape
    return t.reshape(b, s, h, -1).transpose(0, 2, 1, 3)


def from_heads(t):
    b, h, s, d = t.shape
    return t.transpose(0, 2, 1, 3).reshape(b, s, h * d)


def rope(t, positions):
    half = t.shape[-1] // 2
    inv = ROPE_THETA ** (-jnp.arange(half, dtype=jnp.float32) / half)
    ang = positions.astype(jnp.float32)[..., None] * inv
    ang = ang.reshape(ang.shape[:2] + (1,) * (t.ndim - 3) + (half,))
    cos, sin = jnp.cos(ang), jnp.sin(ang)
    t1, t2 = t[..., :half].astype(jnp.float32), t[..., half:].astype(jnp.float32)
    return jnp.concatenate([t1 * cos - t2 * sin, t1 * sin + t2 * cos], axis=-1).astype(t.dtype)


def causal_block_attention(q, k, v, logf_cum=None):
    b, h, s, dk = q.shape
    dv = v.shape[-1]
    nb = s // Q_BLOCK
    scale = dk ** -0.5
    qb = q.reshape(b, h, nb, Q_BLOCK, dk).transpose(2, 0, 1, 3, 4)
    idx = jnp.arange(nb)
    key_pos = jnp.arange(s)
    if logf_cum is None:
        xs = (idx, qb)
    else:
        xs = (idx, qb, logf_cum.reshape(b, h, nb, Q_BLOCK).transpose(2, 0, 1, 3))

    def one(args):
        i, q_i = args[0], args[1]
        sc = jnp.einsum('bhqd,bhkd->bhqk', q_i, k).astype(jnp.float32) * scale
        if logf_cum is not None:
            sc = sc + args[2][..., :, None] - logf_cum[..., None, :]
        qpos = i * Q_BLOCK + jnp.arange(Q_BLOCK)
        mask = key_pos[None, :] <= qpos[:, None]
        p = jax.nn.softmax(jnp.where(mask, sc, -jnp.inf), axis=-1)
        return jnp.einsum('bhqk,bhkd->bhqd', p.astype(v.dtype), v)

    out = lax.map(one, xs)
    return out.transpose(1, 2, 0, 3, 4).reshape(b, h, s, dv)


def gla_chunked(q, k, v, g):
    b, h, s, dk = q.shape
    dv = v.shape[-1]
    L = GLA_CHUNK
    n = s // L

    def chunks(t):
        return t.reshape(b, h, n, L, t.shape[-1]).transpose(2, 0, 1, 3, 4)

    causal = jnp.tril(jnp.ones((L, L), dtype=bool))

    def step(state, inp):
        q_c, k_c, v_c, g_c = inp
        G = jnp.cumsum(g_c, axis=-2)
        o_inter = jnp.einsum('bhld,bhdv->bhlv', q_c * jnp.exp(G), state)
        diff = G[:, :, :, None, :] - G[:, :, None, :, :]
        decay = jnp.exp(jnp.where(causal[:, :, None], diff, -jnp.inf))
        scores = jnp.einsum('bhid,bhjd,bhijd->bhij', q_c, k_c, decay)
        o_intra = jnp.einsum('bhij,bhjv->bhiv', scores, v_c)
        G_last = G[:, :, -1:, :]
        k_dec = k_c * jnp.exp(G_last - G)
        new_state = jnp.exp(G_last[:, :, 0, :])[..., None] * state + jnp.einsum('bhld,bhlv->bhdv', k_dec, v_c)
        return new_state, (o_inter + o_intra).astype(v.dtype)

    state0 = jnp.zeros((b, h, dk, dv), jnp.float32)
    _, o = lax.scan(step, state0, (chunks(q), chunks(k), chunks(v), chunks(g)))
    return o.transpose(1, 2, 0, 3, 4).reshape(b, h, s, dv)


def segsum(a):
    T = a.shape[-1]
    cs = jnp.cumsum(a, axis=-1)
    diff = cs[..., :, None] - cs[..., None, :]
    return jnp.where(jnp.tril(jnp.ones((T, T), dtype=bool)), diff, -jnp.inf)


def ssd_chunked(X, a, Bh, Ch):
    b, s, h, p = X.shape
    n = Bh.shape[-1]
    L = SSM_CHUNK
    c = s // L
    X = X.reshape(b, c, L, h, p)
    Bh = Bh.reshape(b, c, L, h, n)
    Ch = Ch.reshape(b, c, L, h, n)
    a = a.reshape(b, c, L, h).transpose(0, 3, 1, 2)
    a_cs = jnp.cumsum(a, axis=-1)
    Lmat = jnp.exp(segsum(a))
    scores = jnp.einsum('bclhn,bcshn->bhcls', Ch, Bh) * Lmat
    y_diag = jnp.einsum('bhcls,bcshp->bclhp', scores, X)
    decay_states = jnp.exp(a_cs[..., -1:] - a_cs)
    states = jnp.einsum('bclhn,bhcl,bclhp->bchpn', Bh, decay_states, X)
    states = jnp.concatenate([jnp.zeros_like(states[:, :1]), states], axis=1)
    chunk_decay = jnp.exp(segsum(jnp.pad(a_cs[..., -1], ((0, 0), (0, 0), (1, 0)))))
    states = jnp.einsum('bhzc,bchpn->bzhpn', chunk_decay, states)[:, :-1]
    y_off = jnp.einsum('bclhn,bchpn,bhcl->bclhp', Ch, states, jnp.exp(a_cs))
    return (y_diag + y_off).reshape(b, s, h, p)


def causal_depthwise_conv(x, w, bias):
    K, C = w.shape
    y = lax.conv_general_dilated(x, w[:, None, :], window_strides=(1,), padding=[(K - 1, 0)],
                                 dimension_numbers=('NWC', 'WIO', 'NWC'), feature_group_count=C)
    return y + bias


def fox_mixer(q, k, v, f_logit, f_bias):
    logf = jax.nn.log_sigmoid(f_logit.astype(jnp.float32) + f_bias.astype(jnp.float32))
    F = jnp.cumsum(logf, axis=1).transpose(0, 2, 1)
    o = causal_block_attention(to_heads(q, FOX_HEADS), to_heads(k, FOX_HEADS), to_heads(v, FOX_HEADS), F)
    return from_heads(o)


def gla_mixer(q, k, v, r, gate_lr, w2, b2, out_norm):
    b, s, _ = q.shape
    g = jax.nn.log_sigmoid((gate_lr @ w2 + b2).astype(jnp.float32)) / GLA_GATE_TAU
    o = gla_chunked(to_heads(q, GLA_HEADS) * (GLA_DK ** -0.5), to_heads(k, GLA_HEADS),
                    to_heads(v, GLA_HEADS), to_heads(g, GLA_HEADS))
    o = rmsnorm(o.transpose(0, 2, 1, 3), out_norm) * jax.nn.silu(r.reshape(b, s, GLA_HEADS, GLA_DV))
    return o.reshape(b, s, GLA_HEADS * GLA_DV).astype(q.dtype)


def mla_mixer(c_q, c_kv, k_rope, positions, q_norm, w_uq, kv_norm, w_ukv):
    b, s, _ = c_q.shape
    q = (rmsnorm(c_q, q_norm) @ w_uq).reshape(b, s, MLA_HEADS, MLA_NOPE_DIM + MLA_ROPE_DIM)
    q = jnp.concatenate([q[..., :MLA_NOPE_DIM], rope(q[..., MLA_NOPE_DIM:], positions)], axis=-1)
    kv = (rmsnorm(c_kv, kv_norm) @ w_ukv).reshape(b, s, MLA_HEADS, MLA_NOPE_DIM + MLA_V_DIM)
    kr = jnp.broadcast_to(rope(k_rope, positions)[:, :, None, :], (b, s, MLA_HEADS, MLA_ROPE_DIM))
    k = jnp.concatenate([kv[..., :MLA_NOPE_DIM], kr.astype(kv.dtype)], axis=-1)
    v = kv[..., MLA_NOPE_DIM:]
    o = causal_block_attention(q.transpose(0, 2, 1, 3), k.transpose(0, 2, 1, 3), v.transpose(0, 2, 1, 3))
    return from_heads(o)


def mamba2_mixer(z, xbc, dt_raw, conv_w, conv_b, dt_bias, A_log, D_skip, norm_w):
    b, s, _ = z.shape
    xbc = jax.nn.silu(causal_depthwise_conv(xbc, conv_w, conv_b))
    xs, Bm, Cm = split_cols(xbc, (SSM_D_INNER, SSM_GROUPS * SSM_STATE, SSM_GROUPS * SSM_STATE))
    xs = xs.reshape(b, s, SSM_HEADS, SSM_HEAD_DIM)
    rep = SSM_HEADS // SSM_GROUPS
    Bh = jnp.repeat(Bm.reshape(b, s, SSM_GROUPS, SSM_STATE), rep, axis=2)
    Ch = jnp.repeat(Cm.reshape(b, s, SSM_GROUPS, SSM_STATE), rep, axis=2)
    dt = jax.nn.softplus(dt_raw.astype(jnp.float32) + dt_bias.astype(jnp.float32))
    A = -jnp.exp(A_log.astype(jnp.float32))
    y = ssd_chunked(xs * dt[..., None], A * dt, Bh, Ch)
    y = y + D_skip.astype(jnp.float32)[:, None] * xs
    y = (y.reshape(b, s, SSM_D_INNER) * jax.nn.silu(z)).reshape(b, s, SSM_GROUPS, SSM_D_INNER // SSM_GROUPS)
    y = rmsnorm(y, norm_w.reshape(SSM_GROUPS, -1))
    return y.reshape(b, s, SSM_D_INNER).astype(z.dtype)


def setup_inputs(seed: int = 0) -> dict:
    key = jax.random.key(seed)
    ks = jax.random.split(key, 32)
    f32 = jnp.float32

    def nrm(k, shape, scale):
        return jax.random.normal(k, shape, f32) * scale

    def gain(k, shape):
        return 1.0 + 0.02 * jax.random.normal(k, shape, f32)

    x = jax.random.normal(ks[0], (BATCH, SEQ, D_MODEL), f32)
    offset = jax.random.randint(ks[1], (BATCH, 1), 0, 4096, dtype=jnp.int32)
    positions = offset + jnp.arange(SEQ, dtype=jnp.int32)[None, :]
    dt0 = jnp.exp(jax.random.uniform(ks[14], (DEPTH, SSM_HEADS), f32, np.log(1e-3), np.log(1e-1)))
    return {
        "x": x,
        "positions": positions,
        "norm1": gain(ks[2], (DEPTH, D_MODEL)),
        "w_in": nrm(ks[3], (DEPTH, D_MODEL, IN_COLS), D_MODEL ** -0.5),
        "fox_f_bias": jax.random.uniform(ks[4], (DEPTH, FOX_HEADS), f32, 1.0, 5.0),
        "gla_gate_w2": nrm(ks[5], (DEPTH, GLA_GATE_RANK, GLA_HEADS * GLA_DK), GLA_GATE_RANK ** -0.5),
        "gla_gate_b": nrm(ks[6], (DEPTH, GLA_HEADS * GLA_DK), 0.1),
        "gla_out_norm": gain(ks[7], (DEPTH, GLA_DV)),
        "mla_q_norm": gain(ks[8], (DEPTH, MLA_Q_LORA)),
        "mla_w_uq": nrm(ks[9], (DEPTH, MLA_Q_LORA, MLA_HEADS * (MLA_NOPE_DIM + MLA_ROPE_DIM)), MLA_Q_LORA ** -0.5),
        "mla_kv_norm": gain(ks[10], (DEPTH, MLA_KV_LORA)),
        "mla_w_ukv": nrm(ks[11], (DEPTH, MLA_KV_LORA, MLA_HEADS * (MLA_NOPE_DIM + MLA_V_DIM)), MLA_KV_LORA ** -0.5),
        "ssm_conv_w": nrm(ks[12], (DEPTH, SSM_CONV, SSM_CONV_DIM), SSM_CONV ** -0.5),
        "ssm_conv_b": nrm(ks[13], (DEPTH, SSM_CONV_DIM), 0.02),
        "ssm_dt_bias": dt0 + jnp.log(-jnp.expm1(-dt0)),
        "ssm_A_log": jnp.log(jax.random.uniform(ks[15], (DEPTH, SSM_HEADS), f32, 1.0, 16.0)),
        "ssm_D": gain(ks[16], (DEPTH, SSM_HEADS)),
        "ssm_norm": gain(ks[17], (DEPTH, SSM_D_INNER)),
        "w_out": nrm(ks[18], (DEPTH, MIX_WIDTH, D_MODEL), MIX_WIDTH ** -0.5),
        "norm2": gain(ks[19], (DEPTH, D_MODEL)),
        "w_gate": nrm(ks[20], (DEPTH, D_MODEL, FFN_HIDDEN), D_MODEL ** -0.5),
        "w_up": nrm(ks[21], (DEPTH, D_MODEL, FFN_HIDDEN), D_MODEL ** -0.5),
        "w_down": nrm(ks[22], (DEPTH, FFN_HIDDEN, D_MODEL), FFN_HIDDEN ** -0.5),
        "final_norm": gain(ks[23], (D_MODEL,)),
    }


def reference(x, positions, norm1, w_in, fox_f_bias, gla_gate_w2, gla_gate_b, gla_out_norm,
              mla_q_norm, mla_w_uq, mla_kv_norm, mla_w_ukv, ssm_conv_w, ssm_conv_b, ssm_dt_bias,
              ssm_A_log, ssm_D, ssm_norm, w_out, norm2, w_gate, w_up, w_down, final_norm):
    for l in range(DEPTH):
        h = rmsnorm(x, norm1[l])
        (fq, fk, fv, ff, gq, gk, gv, gr, gg, mcq, mckv, mkr, sz, sxbc, sdt) = split_cols(h @ w_in[l], IN_SPLITS)
        y_a = fox_mixer(fq, fk, fv, ff, fox_f_bias[l])
        y_b = gla_mixer(gq, gk, gv, gr, gg, gla_gate_w2[l], gla_gate_b[l], gla_out_norm[l])
        y_c = mla_mixer(mcq, mckv, mkr, positions, mla_q_norm[l], mla_w_uq[l], mla_kv_norm[l], mla_w_ukv[l])
        y_d = mamba2_mixer(sz, sxbc, sdt, ssm_conv_w[l], ssm_conv_b[l], ssm_dt_bias[l], ssm_A_log[l],
                           ssm_D[l], ssm_norm[l])
        mix = jnp.concatenate([y_a, y_b, y_c, y_d], axis=-1)
        x = x + (mix @ w_out[l]).astype(x.dtype)
        h2 = rmsnorm(x, norm2[l])
        x = x + ((jax.nn.silu(h2 @ w_gate[l]) * (h2 @ w_up[l])) @ w_down[l]).astype(x.dtype)
    return rmsnorm(x, final_norm)
```

```cpp
#include <hip/hip_runtime.h>
#include <hip/hip_cooperative_groups.h>
#include <cstdio>
#include <cstdint>
#include <utility>
namespace cg = cooperative_groups;

#ifndef PROBE
#define PROBE 0
#endif
#ifndef MK_COOP
#define MK_COOP 1
#endif

#define DI __device__ __forceinline__
#define LAS __attribute__((address_space(3)))
#define GAS __attribute__((address_space(1)))
typedef unsigned short bf16_t;
typedef short bf16x8 __attribute__((ext_vector_type(8)));
typedef short s16x4 __attribute__((ext_vector_type(4)));
typedef float f32x4 __attribute__((ext_vector_type(4)));
typedef float f32x16 __attribute__((ext_vector_type(16)));
typedef unsigned u32x4 __attribute__((ext_vector_type(4)));
typedef unsigned u32x2 __attribute__((ext_vector_type(2)));
typedef __bf16 bf16x2_t __attribute__((ext_vector_type(2)));
typedef float f32x2_t __attribute__((ext_vector_type(2)));
#define MFMA32(a, b, c) __builtin_amdgcn_mfma_f32_32x32x16_bf16((a), (b), (c), 0, 0, 0)

constexpr int NB = 4, SEQ = 8192, T = NB * SEQ, DM = 1024, FF = 2816, DEPTH = 2;
constexpr int PLD = 3072;
constexpr int C_FQ = 0, C_FK = 256, C_FV = 512, C_GQ = 768, C_GK = 896, C_GV = 1024, C_GR = 1280, C_MCQ = 1536, C_MCKV = 1792, C_MKR = 1920,
              C_GG = 1952, C_FF = 1968, C_DT = 1972, C_SZ = 2048, C_XBC = 2304;
constexpr float EPS = 1e-6f, LOG2E = 1.4426950408889634f;

constexpr size_t MiB = 1u << 20;
constexpr size_t WS_W = 0, W_LAYER = 25 * MiB;
constexpr size_t WO_IN = 0, WO_OUT = 6 * MiB, WO_GU = 8 * MiB, WO_D = 19 * MiB, WO_UQ = 24 * MiB + 512 * 1024, WO_UKV = 24 * MiB + 768 * 1024;
constexpr size_t WS_XB2 = 310 * MiB;
constexpr size_t WS_HM = 50 * MiB, WS_PROJ = 114 * MiB, WS_AUX = 306 * MiB, WS_QM = 310 * MiB, WS_KM = 334 * MiB, WS_VTM = 358 * MiB, WS_VTF = 374 * MiB,
                 WS_G = 390 * MiB, WS_GS = 406 * MiB, WS_XBC = 422 * MiB, WS_SST = 470 * MiB, WS_MISC = 502 * MiB;
constexpr size_t WS_F = WS_MISC, WS_DT = WS_MISC + 512 * 1024, WS_ACS = WS_MISC + 1024 * 1024, WS_RQ = WS_MISC + 1536 * 1024, WS_RKV = WS_RQ + 128 * 1024,
                 WS_GDEC = WS_RKV + 128 * 1024, WS_ROPE = WS_MISC + 2 * MiB, WS_CTR = WS_ROPE + 4 * MiB, WS_SSA = WS_CTR + 4096, WS_SSB = WS_SSA + 128 * 1024, WS_END = WS_SSB + 128 * 1024;
static_assert(WS_END <= 512 * MiB, "ws map");

constexpr int LDS_BYTES = 144 * 1024;

DI unsigned f2bf(float f) { unsigned u = __builtin_bit_cast(unsigned, f); return (u + 0x7fffu + ((u >> 16) & 1u)) >> 16; }
DI float bf2f(unsigned short b) { return __builtin_bit_cast(float, (unsigned)b << 16); }
DI unsigned cvtpk(float lo, float hi) { f32x2_t v = {lo, hi}; bf16x2_t b = __builtin_convertvector(v, bf16x2_t); return __builtin_bit_cast(unsigned, b); }
DI float bflo(unsigned u) { return __builtin_bit_cast(float, u << 16); }
DI float bfhi(unsigned u) { return __builtin_bit_cast(float, u & 0xffff0000u); }
DI int crow(int r, int hi) { return (r & 3) + 8 * (r >> 2) + 4 * hi; }
DI float shx(float v, int m, int lane) { return __builtin_bit_cast(float, __builtin_amdgcn_ds_bpermute((lane ^ m) << 2, __builtin_bit_cast(int, v))); }
DI float wave_sum(float v, int lane) {
#pragma unroll
    for (int o = 1; o < 64; o <<= 1) v += shx(v, o, lane);
    return v;
}
DI float logsigmoidf(float z) { return fminf(z, 0.f) - __logf(1.f + __expf(-fabsf(z))); }
DI float softplusf(float z) { return fmaxf(z, 0.f) + __logf(1.f + __expf(-fabsf(z))); }
DI float siluf(float z) { return z * __builtin_amdgcn_rcpf(1.f + __expf(-z)); }
DI bf16x8 pack8(float a0, float a1, float a2, float a3, float a4, float a5, float a6, float a7) {
    u32x4 p; p.x = cvtpk(a0, a1); p.y = cvtpk(a2, a3); p.z = cvtpk(a4, a5); p.w = cvtpk(a6, a7); return __builtin_bit_cast(bf16x8, p);
}
DI void mm32(f32x16& acc, const LAS bf16_t* A, int lda, const LAS bf16_t* Bt, int ldb, int ksteps, int lane) {
    const int r = lane & 31, h = lane >> 5;
    const LAS bf16_t* ap = A + r * lda + 8 * h; const LAS bf16_t* bp = Bt + r * ldb + 8 * h;
    for (int s = 0; s < ksteps; ++s) {
        bf16x8 a = *(const LAS bf16x8*)(ap + 16 * s); bf16x8 b = *(const LAS bf16x8*)(bp + 16 * s);
        acc = MFMA32(a, b, acc);
    }
}
#define LAUNDER_V(x) asm volatile("" : "+v"(x))
#define LAUNDER_S(x) asm volatile("" : "+s"(x))
DI f32x16 zero16() { f32x16 z; for (int i = 0; i < 16; ++i) z[i] = 0.f; return z; }

namespace pg8 {
constexpr int BM = 256, BK = 64, HALF = 128, HTB = HALF * BK * 2, NXCD = 8, WGM = 8;
__host__ __device__ __forceinline__ int lds_byte(int r, int c) { const int st = (r >> 4) * 2 + (c >> 5), rr = r & 15, cc = c & 31, ob = rr * 64 + cc * 2; return st * 1024 + (ob ^ (((ob >> 9) & 1) << 5)); }
__host__ __device__ __forceinline__ void stage_rc(int b, int& R, int& C) { const int st = b / 1024, sb = b % 1024, swz = sb ^ (((sb >> 9) & 1) << 5); R = (st >> 1) * 16 + swz / 64; C = (st & 1) * 32 + (swz % 64) / 2; }
__host__ __device__ __forceinline__ int perm32(int rho) { const int n = rho >> 4, i = rho & 15; return 8 * (i >> 2) + 4 * n + (i & 3); }
struct Unit { int pm, pn; };
struct Gemm { const bf16_t* A; const bf16_t* Bt; int M, N, K, lda, ldb; };
struct StaticOrder {
    int nM, nN, nwg, G, c;
    __device__ void init(int M, int N, int G_, int c_) { nM = M / BM; nN = N / BM; nwg = nM * nN; G = G_; c = c_; }
    __device__ bool next(int i, Unit& u) const {
        const long L = (long)i * G + c; if (L >= nwg) return false;
        int wgid = (int)L; { const int q = nwg / NXCD, r = nwg % NXCD, xcd = wgid % NXCD, off = wgid / NXCD; wgid = (xcd < r ? xcd * (q + 1) : r * (q + 1) + (xcd - r) * q) + off; }
        const int nig = WGM * nN, gid = wgid / nig, fm = gid * WGM, gsz = (nM - fm) < WGM ? (nM - fm) : WGM;
        u.pm = fm + ((wgid % nig) % gsz); u.pn = (wgid % nig) / gsz; return true;
    }
};
template <class Epi>
__device__ __forceinline__ void gemm_phase(LAS unsigned char* lds, const Gemm g, const StaticOrder& S, const Epi& E, int tid) {
    LAUNDER_V(tid); const int wid = __builtin_amdgcn_readfirstlane(tid >> 6), lane = tid & 63, wr = wid >> 2, wc = wid & 3, fr = lane & 15, fq = lane >> 4;
    int K = g.K, lda = g.lda, ldb = g.ldb; LAUNDER_S(K); LAUNDER_S(lda); LAUNDER_S(ldb); const int nt = K / BK;
    unsigned voffA[2], voffB[2];
#pragma unroll
    for (int i = 0; i < 2; ++i) { int R, C; stage_rc(tid * 16 + i * 8192, R, C); const int Rb = (R & ~31) + perm32(R & 31);
        voffA[i] = (unsigned)(R * lda + C) * 2u; voffB[i] = (unsigned)(Rb * ldb + C) * 2u; }
    const size_t kstep = (size_t)(BK * 2);
    const size_t hstepA = (size_t)HALF * lda * 2, hstepB = (size_t)HALF * ldb * 2;
    const size_t tstepA = 2 * hstepA, tstepB = 2 * hstepB;
    const unsigned ldsw = (unsigned)wid * 1024u;
    const int aoff = lds_byte(wr * 64 + fr, fq * 8), boff = lds_byte(wc * 32 + fr, fq * 8);
#define PG8_SA(b, h) (((b) * 2 + (h)) * HTB)
#define PG8_SB(b, h) ((4 + (b) * 2 + (h)) * HTB)
#define PG8_STAGE(bufoff, gbase, voff) do { _Pragma("unroll") for (int _i = 0; _i < 2; ++_i) \
        __builtin_amdgcn_global_load_lds((const unsigned*)((const char*)(gbase) + (voff)[_i]), (LAS unsigned*)(lds + (bufoff) + ldsw + _i * 8192), 16, 0, 0); } while (0)
#define PG8_LDA(dst, b, h) do { _Pragma("unroll") for (int m = 0; m < 4; ++m) _Pragma("unroll") for (int k = 0; k < 2; ++k) dst[m][k] = *(const LAS bf16x8*)(lds + PG8_SA(b, h) + aoff + m * 2048 + k * 1024); } while (0)
#define PG8_LDB(dst, b, h) do { _Pragma("unroll") for (int n = 0; n < 2; ++n) _Pragma("unroll") for (int k = 0; k < 2; ++k) dst[n][k] = *(const LAS bf16x8*)(lds + PG8_SB(b, h) + boff + n * 2048 + k * 1024); } while (0)
#define PG8_MMA(ai, bj, At, Bt) do { __builtin_amdgcn_s_setprio(1); _Pragma("unroll") for (int m = 0; m < 4; ++m) _Pragma("unroll") for (int n = 0; n < 2; ++n) _Pragma("unroll") for (int k = 0; k < 2; ++k) \
        acc[ai][bj][m][n] = __builtin_amdgcn_mfma_f32_16x16x32_bf16(Bt[n][k], At[m][k], acc[ai][bj][m][n], 0, 0, 0); __builtin_amdgcn_s_setprio(0); } while (0)
#define PG8_WAIT_V(n) asm volatile("s_waitcnt vmcnt(" #n ")" ::: "memory")
#define PG8_WAIT_L(n) asm volatile("s_waitcnt lgkmcnt(" #n ")" ::: "memory")
#define PG8_BAR __builtin_amdgcn_s_barrier()
#define PG8_SCHED __builtin_amdgcn_sched_barrier(0)
    Unit cur, nxt; int ui = 0;
    if (!S.next(0, cur)) return;
    f32x4 acc[2][2][4][2];
#pragma unroll
    for (int a = 0; a < 2; ++a)
#pragma unroll
        for (int b = 0; b < 2; ++b)
#pragma unroll
            for (int m = 0; m < 4; ++m)
#pragma unroll
                for (int n = 0; n < 2; ++n) acc[a][b][m][n] = (f32x4){0.f, 0.f, 0.f, 0.f};
    bf16x8 At[4][2], B0[2][2], B1[2][2];
    const char* cA = (const char*)g.A + (size_t)cur.pm * tstepA; const char* cB = (const char*)g.Bt + (size_t)cur.pn * tstepB;
    PG8_STAGE(PG8_SB(0, 0), cB, voffB); PG8_STAGE(PG8_SB(0, 1), cB + hstepB, voffB); PG8_STAGE(PG8_SA(0, 0), cA, voffA); PG8_STAGE(PG8_SA(0, 1), cA + hstepA, voffA);
    if (wr == 1) PG8_BAR;
    PG8_WAIT_V(2); PG8_BAR;
    PG8_STAGE(PG8_SB(1, 0), cB + kstep, voffB); PG8_STAGE(PG8_SA(1, 0), cA + kstep, voffA); PG8_STAGE(PG8_SB(1, 1), cB + hstepB + kstep, voffB);
    PG8_WAIT_V(6); PG8_BAR;
    for (;;) {
        const bool has_next = S.next(ui + 1, nxt);
        const char* nA = has_next ? (const char*)g.A + (size_t)nxt.pm * tstepA : cA; const char* nB = has_next ? (const char*)g.Bt + (size_t)nxt.pn * tstepB : cB;
        for (int t = 0; t < nt; t += 2) {
            const bool last = (t == nt - 2);
            const char* a1 = cA + (size_t)(t + 1) * kstep;
            const char* a2 = last ? nA : cA + (size_t)(t + 2) * kstep; const char* b2 = last ? nB : cB + (size_t)(t + 2) * kstep;
            const char* a3 = a2 + kstep; const char* b3 = b2 + kstep;
            PG8_LDB(B0, 0, 0); PG8_LDB(B1, 0, 1); PG8_SCHED; PG8_LDA(At, 0, 0); PG8_STAGE(PG8_SA(1, 1), a1 + hstepA, voffA);
            PG8_WAIT_V(8); PG8_WAIT_L(0); PG8_BAR; PG8_MMA(0, 0, At, B0); PG8_MMA(0, 1, At, B1); PG8_BAR; PG8_SCHED;
            PG8_LDA(At, 0, 1); PG8_STAGE(PG8_SB(0, 0), b2, voffB); PG8_STAGE(PG8_SB(0, 1), b2 + hstepB, voffB); PG8_STAGE(PG8_SA(0, 0), a2, voffA);
            PG8_WAIT_V(8); PG8_WAIT_L(0); PG8_BAR; PG8_MMA(1, 0, At, B0); PG8_MMA(1, 1, At, B1); PG8_BAR; PG8_SCHED;
            PG8_LDB(B0, 1, 0); PG8_LDB(B1, 1, 1); PG8_SCHED; PG8_LDA(At, 1, 0); PG8_STAGE(PG8_SA(0, 1), a2 + hstepA, voffA);
            PG8_WAIT_V(8); PG8_WAIT_L(0); PG8_BAR; PG8_MMA(0, 0, At, B0); PG8_MMA(0, 1, At, B1); PG8_BAR; PG8_SCHED;
            PG8_LDA(At, 1, 1); PG8_STAGE(PG8_SB(1, 0), b3, voffB); PG8_STAGE(PG8_SB(1, 1), b3 + hstepB, voffB); PG8_STAGE(PG8_SA(1, 0), a3, voffA);
            PG8_WAIT_V(8); PG8_WAIT_L(0); PG8_BAR; PG8_MMA(1, 0, At, B0); PG8_MMA(1, 1, At, B1); PG8_BAR; PG8_SCHED;
        }
        if (wr == 0) PG8_BAR;
        E(acc, cur, wr, wc, fr, fq);
        if (!has_next) break;
#pragma unroll
        for (int a = 0; a < 2; ++a)
#pragma unroll
            for (int b = 0; b < 2; ++b)
#pragma unroll
                for (int m = 0; m < 4; ++m)
#pragma unroll
                    for (int n = 0; n < 2; ++n) acc[a][b][m][n] = (f32x4){0.f, 0.f, 0.f, 0.f};
        cur = nxt; cA = nA; cB = nB; ++ui;
        if (wr == 1) PG8_BAR;
    }
    PG8_WAIT_V(0);
    PG8_BAR;
#undef PG8_SA
#undef PG8_SB
#undef PG8_STAGE
#undef PG8_LDA
#undef PG8_LDB
#undef PG8_MMA
#undef PG8_WAIT_V
#undef PG8_WAIT_L
#undef PG8_BAR
#undef PG8_SCHED
}
typedef const f32x4 (&AccRef)[2][2][4][2];
DI u32x4 pk8(f32x4 v0, f32x4 v1) { u32x4 w; w.x = cvtpk(v0[0], v0[1]); w.y = cvtpk(v0[2], v0[3]); w.z = cvtpk(v1[0], v1[1]); w.w = cvtpk(v1[2], v1[3]); return w; }

struct EpiProj {
    bf16_t* O; float* aux; const float* ss;
    DI void operator()(AccRef acc, const Unit& u, int wr, int wc, int fr, int fq) const {
        const int row0 = u.pm * BM + wr * 64 + fr, col0 = u.pn * BM + wc * 32 + 8 * fq;
        float ri[2][4];
#pragma unroll
        for (int ai = 0; ai < 2; ++ai)
#pragma unroll
            for (int m = 0; m < 4; ++m) ri[ai][m] = *(const GAS float*)(ss + row0 + ai * HALF + m * 16);
#pragma unroll
        for (int ai = 0; ai < 2; ++ai)
#pragma unroll
            for (int m = 0; m < 4; ++m) ri[ai][m] = rsqrtf(ri[ai][m] * (1.f / DM) + EPS);
#pragma unroll
        for (int ai = 0; ai < 2; ++ai)
#pragma unroll
            for (int m = 0; m < 4; ++m) { const int row = row0 + ai * HALF + m * 16; bf16_t* rowp = O + (size_t)row * PLD + col0; const float r1 = ri[ai][m];
#pragma unroll
                for (int bj = 0; bj < 2; ++bj) { const f32x4 v0 = acc[ai][bj][m][0] * r1, v1 = acc[ai][bj][m][1] * r1; *(u32x4*)(rowp + bj * HALF) = pk8(v0, v1);
                    if (bj == 1 && u.pn == 7 && wc == 1) { float* ap = aux + (size_t)row * 32 + 8 * fq; *(f32x4*)ap = v0; *(f32x4*)(ap + 4) = v1; } } }
    }
};
struct EpiResid {
    const void* src; int srcbf; bf16_t* dst; float* ss;
    DI void tail(const u32x4 (&pk)[2], size_t ro, int row, int lane, int fq) const {
        float sq = 0.f;
#pragma unroll
        for (int bj = 0; bj < 2; ++bj) { *(GAS u32x4*)(dst + ro + bj * HALF) = pk[bj];
#pragma unroll
            for (int e = 0; e < 4; ++e) sq += bflo(pk[bj][e]) * bflo(pk[bj][e]) + bfhi(pk[bj][e]) * bfhi(pk[bj][e]); }
        sq += shx(sq, 16, lane); sq += shx(sq, 32, lane);
        if (fq == 0) __hip_atomic_fetch_add((GAS float*)(ss + row), sq, __ATOMIC_RELAXED, __HIP_MEMORY_SCOPE_AGENT);
    }
    DI void operator()(AccRef acc, const Unit& u, int wr, int wc, int fr, int fq) const {
        const int row0 = u.pm * BM + wr * 64 + fr, col0 = u.pn * BM + wc * 32 + 8 * fq; const int lane = fr + 16 * fq;
        if (srcbf) {
#pragma unroll
            for (int ai = 0; ai < 2; ++ai) { u32x4 sv[4][2];
#pragma unroll
                for (int m = 0; m < 4; ++m)
#pragma unroll
                    for (int bj = 0; bj < 2; ++bj) sv[m][bj] = *(const GAS u32x4*)((const bf16_t*)src + (size_t)(row0 + ai * HALF + m * 16) * DM + col0 + bj * HALF);
#pragma unroll
                for (int m = 0; m < 4; ++m) { const int row = row0 + ai * HALF + m * 16; const size_t ro = (size_t)row * DM + col0; u32x4 pk[2];
#pragma unroll
                    for (int bj = 0; bj < 2; ++bj) { const u32x4 v = sv[m][bj];
                        pk[bj] = pk8((f32x4){bflo(v.x), bfhi(v.x), bflo(v.y), bfhi(v.y)} + acc[ai][bj][m][0], (f32x4){bflo(v.z), bfhi(v.z), bflo(v.w), bfhi(v.w)} + acc[ai][bj][m][1]); }
                    tail(pk, ro, row, lane, fq); } }
        } else {
#pragma unroll
            for (int ai = 0; ai < 2; ++ai) { f32x4 sf[4][2][2];
#pragma unroll
                for (int m = 0; m < 4; ++m)
#pragma unroll
                    for (int bj = 0; bj < 2; ++bj) { const float* sp = (const float*)src + (size_t)(row0 + ai * HALF + m * 16) * DM + col0 + bj * HALF; sf[m][bj][0] = *(const GAS f32x4*)sp; sf[m][bj][1] = *(const GAS f32x4*)(sp + 4); }
#pragma unroll
                for (int m = 0; m < 4; ++m) { const int row = row0 + ai * HALF + m * 16; const size_t ro = (size_t)row * DM + col0; u32x4 pk[2];
#pragma unroll
                    for (int bj = 0; bj < 2; ++bj) pk[bj] = pk8(sf[m][bj][0] + acc[ai][bj][m][0], sf[m][bj][1] + acc[ai][bj][m][1]);
                    tail(pk, ro, row, lane, fq); } }
        }
    }
};
struct EpiSwiglu {
    bf16_t* O; const float* ss;
    DI void operator()(AccRef acc, const Unit& u, int wr, int wc, int fr, int fq) const {
        const int row0 = u.pm * BM + wr * 64 + fr, col0 = (u.pn * BM + wc * 32 + 8 * fq) >> 1;
        float ri[2][4];
#pragma unroll
        for (int ai = 0; ai < 2; ++ai)
#pragma unroll
            for (int m = 0; m < 4; ++m) ri[ai][m] = *(const GAS float*)(ss + row0 + ai * HALF + m * 16);
#pragma unroll
        for (int ai = 0; ai < 2; ++ai)
#pragma unroll
            for (int m = 0; m < 4; ++m) ri[ai][m] = rsqrtf(ri[ai][m] * (1.f / DM) + EPS);
#pragma unroll
        for (int ai = 0; ai < 2; ++ai)
#pragma unroll
            for (int m = 0; m < 4; ++m) { const int row = row0 + ai * HALF + m * 16; bf16_t* rowp = O + (size_t)row * FF + col0; const float r1 = ri[ai][m];
#pragma unroll
                for (int bj = 0; bj < 2; ++bj) { const f32x4 v0 = acc[ai][bj][m][0] * r1, v1 = acc[ai][bj][m][1] * r1;
                    u32x2 w; w.x = cvtpk(siluf(v0[0]) * v0[1], siluf(v0[2]) * v0[3]); w.y = cvtpk(siluf(v1[0]) * v1[1], siluf(v1[2]) * v1[3]);
                    *(u32x2*)(rowp + bj * (HALF / 2)) = w; } }
    }
};
struct EpiScale {
    bf16_t* O; int ldo; const float* rs; int ncols;
    DI void operator()(AccRef acc, const Unit& u, int wr, int wc, int fr, int fq) const {
        const int row0 = u.pm * BM + wr * 64 + fr, col0 = u.pn * BM + wc * 32 + 8 * fq;
        float ri[2][4];
#pragma unroll
        for (int ai = 0; ai < 2; ++ai)
#pragma unroll
            for (int m = 0; m < 4; ++m) ri[ai][m] = *(const GAS float*)(rs + row0 + ai * HALF + m * 16);
#pragma unroll
        for (int ai = 0; ai < 2; ++ai)
#pragma unroll
            for (int m = 0; m < 4; ++m) { const int row = row0 + ai * HALF + m * 16; const float r1 = ri[ai][m]; bf16_t* rowp = O + (size_t)row * ldo + col0;
#pragma unroll
                for (int bj = 0; bj < 2; ++bj) if (col0 + bj * HALF < ncols) *(u32x4*)(rowp + bj * HALF) = pk8(acc[ai][bj][m][0] * r1, acc[ai][bj][m][1] * r1); }
    }
};
}

struct Args {
    const float* x; const int* pos; const float* norm1; const float* w_in; const float* fox_b; const float* gla_w2; const float* gla_b; const float* gla_on;
    const float* mla_qn; const float* mla_wuq; const float* mla_kvn; const float* mla_wukv; const float* conv_w; const float* conv_b; const float* dt_bias;
    const float* A_log; const float* ssm_D; const float* ssm_norm; const float* w_out; const float* norm2; const float* w_gate; const float* w_up;
    const float* w_down; const float* final_norm;
    float* out; unsigned char* ws; int ph_lo, ph_hi;
};

template <int MAP> DI void wmap(const Args& a, int l, int n, const float*& W, int& ldw, int& col, float& sc) {
    sc = 1.f; col = -1; W = nullptr; ldw = 0;
    if (MAP == 0) {
        W = a.w_in + (size_t)l * DM * 3000; ldw = 3000;
        if (n < 256) { col = n; sc = 0.125f * LOG2E; }
        else if (n < 768) col = n;
        else if (n < 896) { col = 772 + (n - 768); sc = 0.17677669529663687f; }
        else if (n < 1024) col = 900 + (n - 896);
        else if (n < 1280) col = 1028 + (n - 1024);
        else if (n < 1536) col = 1284 + (n - 1280);
        else if (n < 1792) col = 1556 + (n - 1536);
        else if (n < 1920) col = 1812 + (n - 1792);
        else if (n < 1952) { const int jj = n - 1920; col = 1940 + (jj >> 1) + 16 * (jj & 1); }
        else if (n < 1968) col = 1540 + (n - 1952);
        else if (n < 1972) col = 768 + (n - 1968);
        else if (n < 1976) col = 2996 + (n - 1972);
        else if (n < 2048) col = -1;
        else if (n < 2304) col = 1972 + (n - 2048);
        else col = 2228 + (n - 2304);
    } else if (MAP == 1) { W = a.w_out + (size_t)l * DM * DM; ldw = DM; col = n; }
    else if (MAP == 2) { W = ((n & 1) ? a.w_up : a.w_gate) + (size_t)l * DM * FF; ldw = FF; col = n >> 1; }
    else if (MAP == 3) { W = a.w_down + (size_t)l * FF * DM; ldw = DM; col = n; }
    else if (MAP == 4) { W = a.mla_wuq + (size_t)l * 256 * 384; ldw = 384; sc = 0.10206207261596577f * LOG2E;
        if (n < 384) { const int head = n / 96, c = n % 96; if (c < 64) col = head * 96 + c; else { const int jj = c - 64; col = head * 96 + 64 + (jj >> 1) + 16 * (jj & 1); } } }
    else { W = a.mla_wukv + (size_t)l * 128 * 512; ldw = 512;
        if (n < 256) col = (n >> 6) * 128 + (n & 63); else col = ((n - 256) >> 6) * 128 + 64 + (n & 63); }
}
template <int MAP> DI void conv_item(const Args& a, int l, const float* gain, bf16_t* dst, int K, int nblk, int item, LAS float* scr, int lane) {
    const int kb = item / nblk, nb = item % nblk, k0 = 64 * kb, n0 = 32 * nb;
    const float* W; int ldw, col; float sc; wmap<MAP>(a, l, n0 + (lane & 31), W, ldw, col, sc);
#pragma unroll
    for (int i = 0; i < 32; ++i) { const int kk = 2 * i + (lane >> 5); float v = 0.f; if (col >= 0) v = *(const GAS float*)(W + (size_t)(k0 + kk) * ldw + col) * sc; if (gain) v *= *(const GAS float*)(gain + k0 + kk); scr[kk * 33 + (lane & 31)] = v; }
    __builtin_amdgcn_fence(__ATOMIC_RELEASE, "wavefront"); __builtin_amdgcn_wave_barrier(); __builtin_amdgcn_fence(__ATOMIC_ACQUIRE, "wavefront");
    const int c = lane & 7;
#pragma unroll
    for (int j = 0; j < 4; ++j) { const int n = (lane >> 3) + 8 * j; const LAS float* s = scr + (8 * c) * 33 + n;
        u32x4 o; o.x = cvtpk(s[0 * 33], s[1 * 33]); o.y = cvtpk(s[2 * 33], s[3 * 33]); o.z = cvtpk(s[4 * 33], s[5 * 33]); o.w = cvtpk(s[6 * 33], s[7 * 33]);
        *(u32x4*)(dst + (size_t)(n0 + n) * K + k0 + 8 * c) = o; }
    __builtin_amdgcn_fence(__ATOMIC_RELEASE, "wavefront"); __builtin_amdgcn_wave_barrier(); __builtin_amdgcn_fence(__ATOMIC_ACQUIRE, "wavefront");
}
constexpr int CONV_IL = 16 * 96 + 16 * 32 + 16 * 176 + 44 * 32 + 4 * 16 + 2 * 16;
DI void phase_convert(const Args& a, LAS unsigned char* lds, int gw, int NGW, int wave, int lane, int it_begin, int it_end) {
    LAS float* scr = (LAS float*)(lds + wave * 8704);
    constexpr int I0 = 16 * 96, I1 = 16 * 32, I2 = 16 * 176, I3 = 44 * 32, I4 = 4 * 16, I5 = 2 * 16, IL = I0 + I1 + I2 + I3 + I4 + I5;
    static_assert(IL == CONV_IL, "items per layer");
    for (int it = it_begin + gw; it < it_end; it += NGW) {
        const int l = it / IL; int r = it % IL; unsigned char* wl = a.ws + WS_W + (size_t)l * W_LAYER;
        if (r < I0) { conv_item<0>(a, l, a.norm1 + l * DM, (bf16_t*)(wl + WO_IN), DM, 96, r, scr, lane); continue; } r -= I0;
        if (r < I1) { conv_item<1>(a, l, nullptr, (bf16_t*)(wl + WO_OUT), DM, 32, r, scr, lane); continue; } r -= I1;
        if (r < I2) { conv_item<2>(a, l, a.norm2 + l * DM, (bf16_t*)(wl + WO_GU), DM, 176, r, scr, lane); continue; } r -= I2;
        if (r < I3) { conv_item<3>(a, l, nullptr, (bf16_t*)(wl + WO_D), FF, 32, r, scr, lane); continue; } r -= I3;
        if (r < I4) { conv_item<4>(a, l, a.mla_qn + l * 256, (bf16_t*)(wl + WO_UQ), 256, 16, r, scr, lane); continue; } r -= I4;
        conv_item<5>(a, l, a.mla_kvn + l * 128, (bf16_t*)(wl + WO_UKV), 128, 16, r, scr, lane);
    }
}
DI void phase_x_to_bf16(const float* X, bf16_t* H, float* ss, int gw, int NGW, int lane) {
    for (int m0 = gw * 4; m0 < T; m0 += NGW * 4) {
        f32x4 v[4][4];
#pragma unroll
        for (int q = 0; q < 4; ++q) { const f32x4* xr = (const f32x4*)(X + (size_t)(m0 + q) * DM) + lane;
#pragma unroll
            for (int j = 0; j < 4; ++j) v[q][j] = xr[64 * j]; }
#pragma unroll
        for (int q = 0; q < 4; ++q) { float s = 0.f;
#pragma unroll
            for (int j = 0; j < 4; ++j) s += (v[q][j].x * v[q][j].x + v[q][j].y * v[q][j].y) + (v[q][j].z * v[q][j].z + v[q][j].w * v[q][j].w);
            s = wave_sum(s, lane); if (lane == 0) ss[m0 + q] = s;
            u32x2* o = (u32x2*)(H + (size_t)(m0 + q) * DM) + lane;
#pragma unroll
            for (int j = 0; j < 4; ++j) { u32x2 w; w.x = cvtpk(v[q][j].x, v[q][j].y); w.y = cvtpk(v[q][j].z, v[q][j].w); o[64 * j] = w; } }
    }
}
DI void phase_final_norm(const bf16_t* X, float* out, const float* gain, const float* ss, int gw, int NGW, int lane) {
    f32x4 g[4];
#pragma unroll
    for (int j = 0; j < 4; ++j) g[j] = ((const f32x4*)gain)[lane + 64 * j];
    for (int m0 = gw * 4; m0 < T; m0 += NGW * 4) {
        u32x2 v[4][4]; float ri[4];
#pragma unroll
        for (int q = 0; q < 4; ++q) { const u32x2* xr = (const u32x2*)(X + (size_t)(m0 + q) * DM) + lane; ri[q] = ss[m0 + q];
#pragma unroll
            for (int j = 0; j < 4; ++j) v[q][j] = xr[64 * j]; }
#pragma unroll
        for (int q = 0; q < 4; ++q) { f32x4* orow = (f32x4*)(out + (size_t)(m0 + q) * DM) + lane; const float r1 = rsqrtf(ri[q] * (1.f / DM) + EPS);
#pragma unroll
            for (int j = 0; j < 4; ++j) orow[64 * j] = (f32x4){bflo(v[q][j].x) * r1 * g[j][0], bfhi(v[q][j].x) * r1 * g[j][1], bflo(v[q][j].y) * r1 * g[j][2], bfhi(v[q][j].y) * r1 * g[j][3]}; }
    }
}
DI void transpose_tile(const bf16_t* src, int ld, bf16_t* dst, LAS bf16_t* scr, int lane) {
#pragma unroll
    for (int i = 0; i < 8; ++i) { const int row = i * 8 + (lane >> 3), ch = lane & 7;
        const u32x4 v = *(const u32x4*)(src + (size_t)row * ld + ch * 8);
        LAS unsigned* d = (LAS unsigned*)(scr + row * 66 + ch * 8); d[0] = v.x; d[1] = v.y; d[2] = v.z; d[3] = v.w; }
    __builtin_amdgcn_fence(__ATOMIC_RELEASE, "wavefront"); __builtin_amdgcn_wave_barrier(); __builtin_amdgcn_fence(__ATOMIC_ACQUIRE, "wavefront");
#pragma unroll
    for (int i = 0; i < 8; ++i) { const int dv = i * 8 + (lane >> 3), ch = lane & 7; const LAS bf16_t* sp = scr + (ch * 8) * 66 + dv;
        u32x4 o; o.x = sp[0] | ((unsigned)sp[66] << 16); o.y = sp[2 * 66] | ((unsigned)sp[3 * 66] << 16); o.z = sp[4 * 66] | ((unsigned)sp[5 * 66] << 16); o.w = sp[6 * 66] | ((unsigned)sp[7 * 66] << 16);
        *(u32x4*)(dst + (size_t)dv * SEQ + ch * 8) = o; }
    __builtin_amdgcn_fence(__ATOMIC_RELEASE, "wavefront"); __builtin_amdgcn_wave_barrier(); __builtin_amdgcn_fence(__ATOMIC_ACQUIRE, "wavefront");
}
DI void phase_prep(const Args& a, int l, LAS unsigned char* lds, int tid) {
    const int wave = tid >> 6, lane = tid & 63, G = gridDim.x, gw = blockIdx.x * 8 + wave, NGW = G * 8, gws = wave * G + blockIdx.x;
    unsigned char* ws = a.ws;
    const bf16_t* proj = (const bf16_t*)(ws + WS_PROJ); const float* aux = (const float*)(ws + WS_AUX);
    { float* ssa = (float*)(ws + WS_SSA); float* ssb = (float*)(ws + WS_SSB); for (int i = blockIdx.x * 512 + tid; i < T; i += G * 512) { ssa[i] = 0.f; ssb[i] = 0.f; } }
    {
        LAS float* red = (LAS float*)(lds + 139264);
        float* F = (float*)(ws + WS_F);
        for (int bh = (G >= 256 && (blockIdx.x & 15) == 5) ? (int)(blockIdx.x >> 4) : ((G >= 256) ? 16 : (int)blockIdx.x); bh < 16; bh += G) {
            const int b = bh >> 2, h = bh & 3; const float bias = a.fox_b[l * 4 + h];
            float v[16]; float run = 0.f;
#pragma unroll
            for (int i = 0; i < 16; ++i) { const int s = tid * 16 + i; run += logsigmoidf(aux[(size_t)(b * SEQ + s) * 32 + 16 + h] + bias); v[i] = run; }
            float inc = run;
#pragma unroll
            for (int o = 1; o < 64; o <<= 1) { const float t = __builtin_bit_cast(float, __builtin_amdgcn_ds_bpermute(((lane - o) & 63) << 2, __builtin_bit_cast(int, inc))); if (lane >= o) inc += t; }
            __syncthreads();
            if (lane == 63) red[wave] = inc;
            __syncthreads();
            float base = inc - run; for (int w = 0; w < wave; ++w) base += red[w];
#pragma unroll
            for (int i = 0; i < 16; ++i) F[(size_t)bh * SEQ + tid * 16 + i] = (base + v[i]) * LOG2E;
        }
    }
    {
        LAS bf16_t* scr = (LAS bf16_t*)(lds + wave * 8704); bf16_t* vt = (bf16_t*)(ws + WS_VTF); int* qkn = (int*)(ws + WS_CTR + 256) + l * 32;
        for (int it = gw; it < 16 * 128; it += NGW) {
            const int bh = it >> 7, tile = it & 127, b = bh >> 2, h = bh & 3, s0 = tile * 64;
            const bf16_t* qp = proj + (size_t)(b * SEQ + s0) * PLD + C_FQ + h * 64; const bf16_t* kp = proj + (size_t)(b * SEQ + s0) * PLD + C_FK + h * 64;
            float qm = 0.f, km = 0.f;
#pragma unroll
            for (int i = 0; i < 8; ++i) { const int row = i * 8 + (lane >> 3), ch = lane & 7; const u32x4 qv = *(const u32x4*)(qp + (size_t)row * PLD + ch * 8), kv = *(const u32x4*)(kp + (size_t)row * PLD + ch * 8);
                float sq = 0.f, sk = 0.f;
#pragma unroll
                for (int e = 0; e < 4; ++e) { sq += bflo(qv[e]) * bflo(qv[e]) + bfhi(qv[e]) * bfhi(qv[e]); sk += bflo(kv[e]) * bflo(kv[e]) + bfhi(kv[e]) * bfhi(kv[e]); }
#pragma unroll
                for (int o = 1; o < 8; o <<= 1) { sq += shx(sq, o, lane); sk += shx(sk, o, lane); }
                qm = fmaxf(qm, sq); km = fmaxf(km, sk); }
#pragma unroll
            for (int o = 8; o < 64; o <<= 1) { qm = fmaxf(qm, shx(qm, o, lane)); km = fmaxf(km, shx(km, o, lane)); }
            if (lane == 0) { __hip_atomic_fetch_max(qkn + bh, __builtin_bit_cast(int, qm), __ATOMIC_RELAXED, __HIP_MEMORY_SCOPE_AGENT); __hip_atomic_fetch_max(qkn + 16 + bh, __builtin_bit_cast(int, km), __ATOMIC_RELAXED, __HIP_MEMORY_SCOPE_AGENT); }
            transpose_tile(proj + (size_t)(b * SEQ + s0) * PLD + C_FV + h * 64, PLD, vt + (size_t)bh * 64 * SEQ + s0, scr, lane);
        }
    }
    {
        float* rq = (float*)(ws + WS_RQ); float* rkv = (float*)(ws + WS_RKV); float* rope = (float*)(ws + WS_ROPE); bf16_t* km = (bf16_t*)(ws + WS_KM);
        const int g4 = lane >> 4, j = lane & 15; const float inv = exp2f(-(float)j * (13.287712379549449f / 16.f));
        for (int t4 = gw; t4 < T / 4; t4 += NGW) {
            const int t = t4 * 4 + g4; const bf16_t* pr = proj + (size_t)t * PLD;
            const u32x4 q0 = *(const u32x4*)(pr + C_MCQ + j * 16), q1 = *(const u32x4*)(pr + C_MCQ + j * 16 + 8), kv = *(const u32x4*)(pr + C_MCKV + j * 8);
            const unsigned kr = *(const unsigned*)(pr + C_MKR + 2 * j); const float posf = (float)a.pos[t];
            float sq = 0.f, skv = 0.f;
#pragma unroll
            for (int e = 0; e < 4; ++e) { sq += bflo(q0[e]) * bflo(q0[e]) + bfhi(q0[e]) * bfhi(q0[e]) + bflo(q1[e]) * bflo(q1[e]) + bfhi(q1[e]) * bfhi(q1[e]); skv += bflo(kv[e]) * bflo(kv[e]) + bfhi(kv[e]) * bfhi(kv[e]); }
#pragma unroll
            for (int o = 1; o < 16; o <<= 1) { sq += shx(sq, o, lane); skv += shx(skv, o, lane); }
            if (j == 0) { rq[t] = rsqrtf(sq * (1.f / 256) + EPS); rkv[t] = rsqrtf(skv * (1.f / 128) + EPS); }
            const float ang = posf * inv;
            const float k = rintf(ang * 0.15915494309189535f); float rr = fmaf(-k, 6.28125f, ang); rr = fmaf(-k, 1.9353071795864769e-3f, rr);
            const float c = __cosf(rr), sn = __sinf(rr);
            *(f32x2_t*)(rope + (size_t)t * 32 + 2 * j) = (f32x2_t){c, sn};
            const float t1 = bflo(kr), t2 = bfhi(kr);
            const unsigned o = cvtpk(t1 * c - t2 * sn, t1 * sn + t2 * c);
#pragma unroll
            for (int hh = 0; hh < 4; ++hh) *(unsigned*)(km + (size_t)t * 384 + hh * 96 + 64 + 2 * j) = o;
        }
    }
    {
        float* Gp = (float*)(ws + WS_G);
        for (int it = gws; it < 1024; it += NGW) {
            const int ch = it & 1, bc = it >> 1, col = ch * 64 + lane; const int t0 = bc * 64;
            float w2[16];
#pragma unroll
            for (int r = 0; r < 16; ++r) w2[r] = a.gla_w2[(size_t)l * 16 * 128 + r * 128 + col];
            const float b2 = a.gla_b[l * 128 + col]; float run = 0.f;
            const float* ap = aux + (size_t)(t0 + lane) * 32; float gg[16];
#pragma unroll
            for (int q = 0; q < 4; ++q) { const f32x4 g4 = *(const f32x4*)(ap + 4 * q); gg[4 * q] = g4[0]; gg[4 * q + 1] = g4[1]; gg[4 * q + 2] = g4[2]; gg[4 * q + 3] = g4[3]; }
#pragma unroll 4
            for (int i = 0; i < 64; ++i) { float z = b2;
#pragma unroll
                for (int r = 0; r < 16; ++r) z += __builtin_bit_cast(float, __builtin_amdgcn_readlane(__builtin_bit_cast(int, gg[r]), i)) * w2[r];
                run += logsigmoidf(z) * (1.f / 16.f);
                Gp[(size_t)(t0 + i) * 128 + col] = run; }
        }
    }
    {
        bf16_t* xbc = (bf16_t*)(ws + WS_XBC);
        for (int it = blockIdx.x; it < T / 32; it += G) {
            if (tid < 384) { const int cg = tid % 96, ts = tid / 96, c0 = cg * 8, t0 = it * 32 + ts * 8;
                float w[4][8], bias[8];
#pragma unroll
                for (int k = 0; k < 4; ++k)
#pragma unroll
                    for (int e = 0; e < 8; ++e) w[k][e] = a.conv_w[(size_t)l * 4 * 768 + k * 768 + c0 + e];
#pragma unroll
                for (int e = 0; e < 8; ++e) bias[e] = a.conv_b[l * 768 + c0 + e];
                u32x4 win[3];
#pragma unroll
                for (int k = 0; k < 3; ++k) { const int t = t0 - 3 + k; win[k] = (u32x4){0u, 0u, 0u, 0u}; if ((t0 & (SEQ - 1)) + k - 3 >= 0) win[k] = *(const u32x4*)(proj + (size_t)t * PLD + C_XBC + c0); }
                u32x4 rows8[8];
#pragma unroll
                for (int i = 0; i < 8; ++i) rows8[i] = *(const u32x4*)(proj + (size_t)(t0 + i) * PLD + C_XBC + c0);
#pragma unroll
                for (int i = 0; i < 8; ++i) { const int t = t0 + i; const u32x4 cur = rows8[i];
                    float o[8];
#pragma unroll
                    for (int e = 0; e < 4; ++e) {
                        o[2 * e] = bias[2 * e] + w[0][2 * e] * bflo(win[0][e]) + w[1][2 * e] * bflo(win[1][e]) + w[2][2 * e] * bflo(win[2][e]) + w[3][2 * e] * bflo(cur[e]);
                        o[2 * e + 1] = bias[2 * e + 1] + w[0][2 * e + 1] * bfhi(win[0][e]) + w[1][2 * e + 1] * bfhi(win[1][e]) + w[2][2 * e + 1] * bfhi(win[2][e]) + w[3][2 * e + 1] * bfhi(cur[e]); }
                    u32x4 ov; ov.x = cvtpk(siluf(o[0]), siluf(o[1])); ov.y = cvtpk(siluf(o[2]), siluf(o[3])); ov.z = cvtpk(siluf(o[4]), siluf(o[5])); ov.w = cvtpk(siluf(o[6]), siluf(o[7]));
                    *(u32x4*)(xbc + (size_t)t * 768 + c0) = ov;
                    win[0] = win[1]; win[1] = win[2]; win[2] = cur; }
            }
        }
    }
    {
        float* DT = (float*)(ws + WS_DT); float* ACS = (float*)(ws + WS_ACS);
        f32x4 bias, Ah;
#pragma unroll
        for (int h = 0; h < 4; ++h) { bias[h] = a.dt_bias[l * 4 + h]; Ah[h] = -__expf(a.A_log[l * 4 + h]); }
        for (int it = gws; it < 256; it += NGW) {
            const size_t t0 = (size_t)it * 128 + 2 * lane;
            const f32x4 r0 = *(const f32x4*)(aux + t0 * 32 + 20), r1 = *(const f32x4*)(aux + (t0 + 1) * 32 + 20);
            f32x4 dt0, dt1, a0, a1;
#pragma unroll
            for (int h = 0; h < 4; ++h) { dt0[h] = softplusf(r0[h] + bias[h]); dt1[h] = softplusf(r1[h] + bias[h]); a0[h] = Ah[h] * dt0[h]; a1[h] = a0[h] + Ah[h] * dt1[h]; }
            float i0 = a1[0], i1 = a1[1], i2 = a1[2], i3 = a1[3];
#pragma unroll
            for (int o = 1; o < 64; o <<= 1) { const int ad = ((lane - o) & 63) << 2; const bool up = lane >= o;
                const float t0_ = __builtin_bit_cast(float, __builtin_amdgcn_ds_bpermute(ad, __builtin_bit_cast(int, i0)));
                const float t1_ = __builtin_bit_cast(float, __builtin_amdgcn_ds_bpermute(ad, __builtin_bit_cast(int, i1)));
                const float t2_ = __builtin_bit_cast(float, __builtin_amdgcn_ds_bpermute(ad, __builtin_bit_cast(int, i2)));
                const float t3_ = __builtin_bit_cast(float, __builtin_amdgcn_ds_bpermute(ad, __builtin_bit_cast(int, i3)));
                i0 += up ? t0_ : 0.f; i1 += up ? t1_ : 0.f; i2 += up ? t2_ : 0.f; i3 += up ? t3_ : 0.f; }
            const f32x4 inc = {i0, i1, i2, i3};
            const f32x4 base = inc - a1;
            *(f32x4*)(DT + t0 * 4) = dt0; *(f32x4*)(DT + (t0 + 1) * 4) = dt1; *(f32x4*)(ACS + t0 * 4) = base + a0; *(f32x4*)(ACS + (t0 + 1) * 4) = base + a1;
        }
    }
}


DI void phase_mla_post(const Args& a, LAS unsigned char* lds, int tid, int vb) {
    const int wave = tid >> 6, lane = tid & 63, gw = vb * 8 + wave, NGW = 256 * 8; unsigned char* ws = a.ws;
    bf16_t* qm = (bf16_t*)(ws + WS_QM); bf16_t* km = (bf16_t*)(ws + WS_KM); bf16_t* vtm = (bf16_t*)(ws + WS_VTM); const bf16_t* kvraw = (const bf16_t*)a.out + (size_t)T * DM; const float* rope = (const float*)(ws + WS_ROPE);
    { const int hd = lane >> 4, j = lane & 15;
        for (int tb = gw * 4; tb < T; tb += NGW * 4) { unsigned v[4]; f32x2_t cs[4];
#pragma unroll
            for (int q = 0; q < 4; ++q) { v[q] = *(const unsigned*)(qm + (size_t)(tb + q) * 384 + hd * 96 + 64 + 2 * j); cs[q] = *(const f32x2_t*)(rope + (size_t)(tb + q) * 32 + 2 * j); }
#pragma unroll
            for (int q = 0; q < 4; ++q) { const float t1 = bflo(v[q]), t2 = bfhi(v[q]); *(unsigned*)(qm + (size_t)(tb + q) * 384 + hd * 96 + 64 + 2 * j) = cvtpk(t1 * cs[q][0] - t2 * cs[q][1], t1 * cs[q][1] + t2 * cs[q][0]); } } }
    LAS bf16_t* scr = (LAS bf16_t*)(lds + wave * 8704);
    for (int it = gw; it < 16 * 128; it += NGW) {
        const int bh = it >> 7, tile = it & 127, b = bh >> 2, h = bh & 3, s0 = tile * 64; const size_t t0 = (size_t)b * SEQ + s0;
        u32x4 kc[8];
#pragma unroll
        for (int i = 0; i < 8; ++i) { const int row = i * 8 + (lane >> 3), ch = lane & 7; kc[i] = *(const u32x4*)(kvraw + (t0 + row) * 512 + h * 64 + ch * 8); }
#pragma unroll
        for (int i = 0; i < 8; ++i) { const int row = i * 8 + (lane >> 3), ch = lane & 7; *(u32x4*)(km + (t0 + row) * 384 + h * 96 + ch * 8) = kc[i]; }
        transpose_tile(kvraw + t0 * 512 + 256 + h * 64, 512, vtm + (size_t)bh * 64 * SEQ + s0, scr, lane);
    }
}

DI void gla_stage_vt(const bf16_t* proj, int t0, int h, LAS bf16_t* VT, int u) {
    const int li = u >> 1, half = u & 1; const bf16_t* src = proj + (size_t)(t0 + li) * PLD + C_GV + h * 64 + half * 32;
#pragma unroll
    for (int q = 0; q < 4; ++q) { const u32x4 v = *(const u32x4*)(src + q * 8);
#pragma unroll
        for (int e = 0; e < 4; ++e) { VT[(half * 32 + q * 8 + 2 * e) * 72 + li] = (bf16_t)(v[e] & 0xffffu); VT[(half * 32 + q * 8 + 2 * e + 1) * 72 + li] = (bf16_t)(v[e] >> 16); } }
}
DI void phase_gla1(const Args& a, LAS unsigned char* lds, int tid) {
    const int wave = __builtin_amdgcn_readfirstlane(tid >> 6), lane = tid & 63, G = gridDim.x; unsigned char* ws = a.ws;
    const bf16_t* proj = (const bf16_t*)(ws + WS_PROJ); const float* Gp = (const float*)(ws + WS_G); float* GS = (float*)(ws + WS_GS); float* GDEC = (float*)(ws + WS_GDEC);
    constexpr int SLOT = 13824;
    for (int task = blockIdx.x; task < 512; task += G) {
        const int bh = task >> 5, c0 = (task & 31) * 4, b = bh >> 2, h = bh & 3;
        { const int cs = tid >> 7, u = tid & 127, t0 = b * SEQ + (c0 + cs) * 64; LAS bf16_t* KT = (LAS bf16_t*)(lds + cs * SLOT); LAS bf16_t* VT = KT + 32 * 72;
            const int li = u >> 1, dh = u & 1; const bf16_t* ks = proj + (size_t)(t0 + li) * PLD + C_GK + h * 32 + dh * 16; const float* gs = Gp + (size_t)(t0 + li) * 128 + h * 32 + dh * 16;
#pragma unroll
            for (int q = 0; q < 2; ++q) { const u32x4 kv = *(const u32x4*)(ks + q * 8); const f32x4 g0 = *(const f32x4*)(gs + q * 8), g1 = *(const f32x4*)(gs + q * 8 + 4);
#pragma unroll
                for (int e = 0; e < 4; ++e) { const float ga = (e < 2) ? g0[2 * e] : g1[2 * e - 4], gb = (e < 2) ? g0[2 * e + 1] : g1[2 * e - 3];
                    KT[(dh * 16 + q * 8 + 2 * e) * 72 + li] = (bf16_t)f2bf(bflo(kv[e]) * __expf(-ga)); KT[(dh * 16 + q * 8 + 2 * e + 1) * 72 + li] = (bf16_t)f2bf(bfhi(kv[e]) * __expf(-gb)); } }
            gla_stage_vt(proj, t0, h, VT, u); }
        __syncthreads();
        { const int cs = wave >> 1, mt = wave & 1, c = c0 + cs, t0 = b * SEQ + c * 64, r = lane & 31, hh = lane >> 5;
            const LAS bf16_t* KT = (const LAS bf16_t*)(lds + cs * SLOT); const LAS bf16_t* VT = KT + 32 * 72;
            f32x16 acc = zero16(); mm32(acc, VT + mt * 32 * 72, 72, KT, 72, 4, lane);
            const float dec = __expf(Gp[(size_t)(t0 + 63) * 128 + h * 32 + r]);
            float* dst = GS + ((size_t)(bh * 128 + c) * 64) * 32;
#pragma unroll
            for (int i = 0; i < 16; ++i) dst[(mt * 32 + crow(i, hh)) * 32 + r] = acc[i] * dec;
            if (mt == 0 && hh == 0) GDEC[(size_t)(bh * 128 + c) * 32 + r] = dec; }
        __syncthreads();
    }
}
DI void phase_gla2(const Args& a, int tid, int vb) {
    float* GS = (float*)(a.ws + WS_GS); const float* GDEC = (const float*)(a.ws + WS_GDEC);
    if (tid < 128) for (int idx = vb * 128 + tid; idx < 16 * 2048; idx += 256 * 128) {
        const int bh = idx >> 11, e = idx & 2047, d = e & 31; float run = 0.f;
        for (int c0 = 0; c0 < 128; c0 += 16) { float loc[16], dec[16];
#pragma unroll
            for (int j = 0; j < 16; ++j) { loc[j] = GS[(size_t)(bh * 128 + c0 + j) * 2048 + e]; dec[j] = GDEC[(size_t)(bh * 128 + c0 + j) * 32 + d]; }
#pragma unroll
            for (int j = 0; j < 16; ++j) { GS[(size_t)(bh * 128 + c0 + j) * 2048 + e] = run; run = dec[j] * run + loc[j]; } }
    }
}
DI void phase_gla3(const Args& a, int l, LAS unsigned char* lds, int tid, int task0, int tstep) {
    const int wave = __builtin_amdgcn_readfirstlane(tid >> 6), lane = tid & 63, G = gridDim.x; unsigned char* ws = a.ws;
    const bf16_t* proj = (const bf16_t*)(ws + WS_PROJ); const float* Gp = (const float*)(ws + WS_G); const float* GS = (const float*)(ws + WS_GS); bf16_t* mix = (bf16_t*)(ws + WS_HM);
    constexpr int SLOT = 24576;
    for (int task = task0; task < 512; task += tstep) {
        const int bh = task >> 5, c0 = (task & 31) * 4, b = bh >> 2, h = bh & 3;
        { const int cs = tid >> 7, u = tid & 127, c = c0 + cs, t0 = b * SEQ + c * 64;
            LAS bf16_t* QS = (LAS bf16_t*)(lds + cs * SLOT); LAS bf16_t* KS = QS + 64 * 40; LAS bf16_t* VT = KS + 64 * 40; LAS bf16_t* SB = VT + 64 * 72;
            const int li = u >> 1, dh = u & 1; const bf16_t* qs = proj + (size_t)(t0 + li) * PLD + C_GQ + h * 32 + dh * 16; const bf16_t* ks = proj + (size_t)(t0 + li) * PLD + C_GK + h * 32 + dh * 16;
            const float* gs = Gp + (size_t)(t0 + li) * 128 + h * 32 + dh * 16;
#pragma unroll
            for (int q = 0; q < 2; ++q) { const u32x4 qv = *(const u32x4*)(qs + q * 8), kv = *(const u32x4*)(ks + q * 8); const f32x4 g0 = *(const f32x4*)(gs + q * 8), g1 = *(const f32x4*)(gs + q * 8 + 4);
                u32x4 qo, ko;
#pragma unroll
                for (int e = 0; e < 4; ++e) { const float ga = (e < 2) ? g0[2 * e] : g1[2 * e - 4], gb = (e < 2) ? g0[2 * e + 1] : g1[2 * e - 3];
                    qo[e] = cvtpk(bflo(qv[e]) * __expf(ga), bfhi(qv[e]) * __expf(gb)); ko[e] = cvtpk(bflo(kv[e]) * __expf(-ga), bfhi(kv[e]) * __expf(-gb)); }
                *(LAS u32x4*)(QS + li * 40 + dh * 16 + q * 8) = qo; *(LAS u32x4*)(KS + li * 40 + dh * 16 + q * 8) = ko; }
            gla_stage_vt(proj, t0, h, VT, u);
            { const int dv = u >> 1; const float* sp = GS + ((size_t)(bh * 128 + c) * 64 + dv) * 32 + dh * 16;
#pragma unroll
                for (int q = 0; q < 2; ++q) { const f32x4 s0 = *(const f32x4*)(sp + q * 8), s1 = *(const f32x4*)(sp + q * 8 + 4); u32x4 o; o.x = cvtpk(s0[0], s0[1]); o.y = cvtpk(s0[2], s0[3]); o.z = cvtpk(s1[0], s1[1]); o.w = cvtpk(s1[2], s1[3]);
                    *(LAS u32x4*)(SB + dv * 40 + dh * 16 + q * 8) = o; } } }
        __syncthreads();
        { const int cs = wave >> 1, it = wave & 1, c = c0 + cs, t0 = b * SEQ + c * 64, r = lane & 31, hh = lane >> 5;
            const LAS bf16_t* QS = (const LAS bf16_t*)(lds + cs * SLOT); const LAS bf16_t* KS = QS + 64 * 40; const LAS bf16_t* VT = KS + 64 * 40; const LAS bf16_t* SB = VT + 64 * 72;
            f32x16 o[2]; o[0] = zero16(); o[1] = zero16();
            mm32(o[0], SB, 40, QS + it * 32 * 40, 40, 2, lane); mm32(o[1], SB + 32 * 40, 40, QS + it * 32 * 40, 40, 2, lane);
            for (int jt = 0; jt <= it; ++jt) {
                f32x16 st = zero16(); mm32(st, KS + jt * 32 * 40, 40, QS + it * 32 * 40, 40, 2, lane);
                if (jt == it) {
#pragma unroll
                    for (int i = 0; i < 16; ++i) if (crow(i, hh) > r) st[i] = 0.f; }
#pragma unroll
                for (int s = 0; s < 2; ++s) { const bf16x8 pb = pack8(st[8 * s], st[8 * s + 1], st[8 * s + 2], st[8 * s + 3], st[8 * s + 4], st[8 * s + 5], st[8 * s + 6], st[8 * s + 7]);
#pragma unroll
                    for (int dt = 0; dt < 2; ++dt) { const LAS bf16_t* vp = VT + (dt * 32 + r) * 72 + jt * 32 + 16 * s + 4 * hh;
                        const s16x4 lo = *(const LAS s16x4*)vp, hi = *(const LAS s16x4*)(vp + 8); const bf16x8 va = __builtin_shufflevector(lo, hi, 0, 1, 2, 3, 4, 5, 6, 7);
                        o[dt] = MFMA32(va, pb, o[dt]); } }
            }
            float ss = 0.f;
#pragma unroll
            for (int i = 0; i < 16; ++i) ss += o[0][i] * o[0][i] + o[1][i] * o[1][i];
            ss += shx(ss, 32, lane); const float ri = rsqrtf(ss * (1.f / 64) + EPS);
            const int t = t0 + it * 32 + r; const bf16_t* rp = proj + (size_t)t * PLD + C_GR + h * 64; bf16_t* op = mix + (size_t)t * DM + 256 + h * 64;
            u32x2 rvs[2][4]; f32x4 gns[2][4];
#pragma unroll
            for (int dt = 0; dt < 2; ++dt)
#pragma unroll
                for (int g = 0; g < 4; ++g) { rvs[dt][g] = *(const u32x2*)(rp + dt * 32 + 8 * g + 4 * hh); gns[dt][g] = *(const f32x4*)(a.gla_on + l * 64 + dt * 32 + 8 * g + 4 * hh); }
#pragma unroll
            for (int dt = 0; dt < 2; ++dt)
#pragma unroll
                for (int g = 0; g < 4; ++g) { const int dv = dt * 32 + 8 * g + 4 * hh; const u32x2 rv = rvs[dt][g]; const f32x4 gn = gns[dt][g];
                    u32x2 w; w.x = cvtpk(o[dt][4 * g] * ri * gn[0] * siluf(bflo(rv.x)), o[dt][4 * g + 1] * ri * gn[1] * siluf(bfhi(rv.x)));
                    w.y = cvtpk(o[dt][4 * g + 2] * ri * gn[2] * siluf(bflo(rv.y)), o[dt][4 * g + 3] * ri * gn[3] * siluf(bfhi(rv.y)));
                    *(u32x2*)(op + dv) = w; } }
        __syncthreads();
    }
}

DI void phase_ssd1(const Args& a, LAS unsigned char* lds, int tid) {
    const int wave = __builtin_amdgcn_readfirstlane(tid >> 6), lane = tid & 63, G = gridDim.x; unsigned char* ws = a.ws;
    const bf16_t* xbc = (const bf16_t*)(ws + WS_XBC); const float* DT = (const float*)(ws + WS_DT); const float* ACS = (const float*)(ws + WS_ACS); float* SST = (float*)(ws + WS_SST);
    LAS bf16_t* XT = (LAS bf16_t*)lds; LAS bf16_t* BT = XT + 128 * 136;
    for (int task = blockIdx.x; task < 512; task += G) {
        const int g = task & 1, bc = task >> 1, b = bc >> 6, c = bc & 63, t0 = b * SEQ + c * 128;
        { const int li = tid >> 2, qt = tid & 3, hh2 = qt >> 1, head = 2 * g + hh2, t = t0 + li;
            const float sc = DT[(size_t)t * 4 + head] * __expf(ACS[(size_t)(t0 + 127) * 4 + head] - ACS[(size_t)t * 4 + head]);
            const bf16_t* xs = xbc + (size_t)t * 768 + g * 128 + qt * 32; const bf16_t* bs = xbc + (size_t)t * 768 + 256 + g * 128 + qt * 32;
#pragma unroll
            for (int q = 0; q < 4; ++q) { const u32x4 xv = *(const u32x4*)(xs + q * 8), bv = *(const u32x4*)(bs + q * 8);
#pragma unroll
                for (int e = 0; e < 4; ++e) { const int ch = qt * 32 + q * 8 + 2 * e;
                    XT[ch * 136 + li] = (bf16_t)f2bf(bflo(xv[e]) * sc); XT[(ch + 1) * 136 + li] = (bf16_t)f2bf(bfhi(xv[e]) * sc);
                    BT[ch * 136 + li] = (bf16_t)(bv[e] & 0xffffu); BT[(ch + 1) * 136 + li] = (bf16_t)(bv[e] >> 16); } } }
        __syncthreads();
        { const int mt = wave >> 1, r = lane & 31, hh = lane >> 5;
#pragma unroll
            for (int k = 0; k < 2; ++k) { const int nt = 2 * (wave & 1) + k; f32x16 acc = zero16(); mm32(acc, XT + mt * 32 * 136, 136, BT + nt * 32 * 136, 136, 8, lane);
#pragma unroll
                for (int i = 0; i < 16; ++i) { const int hp = mt * 32 + crow(i, hh), head = 2 * g + (hp >> 6), p = hp & 63;
                    SST[(((size_t)(b * 64 + c) * 4 + head) * 64 + p) * 128 + nt * 32 + r] = acc[i]; } } }
        __syncthreads();
    }
}
DI void phase_ssd2(const Args& a, int tid, int vb) {
    float* SST = (float*)(a.ws + WS_SST); const float* ACS = (const float*)(a.ws + WS_ACS);
    for (int idx = vb * 512 + tid; idx < 4 * 32768; idx += 256 * 512) {
        const int b = idx >> 15, rem = idx & 32767, head = rem >> 13, pn = rem & 8191; float run = 0.f;
        for (int c0 = 0; c0 < 64; c0 += 16) { float loc[16], dec[16];
#pragma unroll
            for (int j = 0; j < 16; ++j) { loc[j] = SST[((size_t)(b * 64 + c0 + j) * 4 + head) * 8192 + pn]; dec[j] = __expf(ACS[(size_t)(b * SEQ + (c0 + j) * 128 + 127) * 4 + head]); }
#pragma unroll
            for (int j = 0; j < 16; ++j) { SST[((size_t)(b * 64 + c0 + j) * 4 + head) * 8192 + pn] = run; run = dec[j] * run + loc[j]; } }
    }
}
DI void phase_ssd3(const Args& a, int l, LAS unsigned char* lds, int tid, int task0, int tstep) {
    const int wave = __builtin_amdgcn_readfirstlane(tid >> 6), lane = tid & 63, G = gridDim.x; unsigned char* ws = a.ws;
    const bf16_t* proj = (const bf16_t*)(ws + WS_PROJ); const bf16_t* xbc = (const bf16_t*)(ws + WS_XBC); const float* DT = (const float*)(ws + WS_DT); const float* ACS = (const float*)(ws + WS_ACS);
    const float* SST = (const float*)(ws + WS_SST); bf16_t* mix = (bf16_t*)(ws + WS_HM);
    LAS bf16_t* CS = (LAS bf16_t*)lds; LAS bf16_t* BS = CS + 128 * 136; LAS bf16_t* PS = BS + 128 * 136; LAS bf16_t* XT = PS + 128 * 136; LAS bf16_t* ES = XT + 64 * 136;
    LAS float* ACSs = (LAS float*)(ES + 64 * 136); LAS float* DTs = ACSs + 256; LAS float* Y = (LAS float*)BS;
    for (int task = task0; task < 512; task += tstep) {
        const int g = task & 1, bc = task >> 1, b = bc >> 6, c = bc & 63, t0 = b * SEQ + c * 128;
#pragma unroll
        for (int i = 0; i < 4; ++i) { const int idx = tid + 512 * i, row = idx >> 4, ch = idx & 15;
            *(LAS u32x4*)(CS + row * 136 + ch * 8) = *(const u32x4*)(xbc + (size_t)(t0 + row) * 768 + 512 + g * 128 + ch * 8);
            *(LAS u32x4*)(BS + row * 136 + ch * 8) = *(const u32x4*)(xbc + (size_t)(t0 + row) * 768 + 256 + g * 128 + ch * 8); }
        if (tid < 256) { const int hh2 = tid >> 7, li = tid & 127; ACSs[tid] = ACS[(size_t)(t0 + li) * 4 + 2 * g + hh2]; DTs[tid] = DT[(size_t)(t0 + li) * 4 + 2 * g + hh2]; }
        __syncthreads();
        const int lt = wave >> 1, r = lane & 31, hh = lane >> 5;
        f32x16 sc[2];
#pragma unroll
        for (int k = 0; k < 2; ++k) { const int st = 2 * (wave & 1) + k; sc[k] = zero16(); if (st <= lt) mm32(sc[k], CS + lt * 32 * 136, 136, BS + st * 32 * 136, 136, 8, lane); }
        f32x16 y[2];
#pragma unroll
        for (int hh2 = 0; hh2 < 2; ++hh2) {
            const int head = 2 * g + hh2;
            { const int si = tid >> 2, qt = tid & 3; const float dt = DTs[hh2 * 128 + si]; const bf16_t* xs = xbc + (size_t)(t0 + si) * 768 + head * 64 + qt * 16;
#pragma unroll
                for (int q = 0; q < 2; ++q) { const u32x4 xv = *(const u32x4*)(xs + q * 8);
#pragma unroll
                    for (int e = 0; e < 4; ++e) { const int p = qt * 16 + q * 8 + 2 * e; XT[p * 136 + si] = (bf16_t)f2bf(bflo(xv[e]) * dt); XT[(p + 1) * 136 + si] = (bf16_t)f2bf(bfhi(xv[e]) * dt); } }
                const int p = tid >> 3, ch = tid & 7; const float* sp = SST + (((size_t)(b * 64 + c) * 4 + head) * 64 + p) * 128 + ch * 16;
#pragma unroll
                for (int q = 0; q < 2; ++q) { const f32x4 s0 = *(const f32x4*)(sp + q * 8), s1 = *(const f32x4*)(sp + q * 8 + 4); u32x4 o; o.x = cvtpk(s0[0], s0[1]); o.y = cvtpk(s0[2], s0[3]); o.z = cvtpk(s1[0], s1[1]); o.w = cvtpk(s1[2], s1[3]);
                    *(LAS u32x4*)(ES + p * 136 + ch * 16 + q * 8) = o; } }
#pragma unroll
            for (int k = 0; k < 2; ++k) { const int st = 2 * (wave & 1) + k; if (st <= lt) { const int s = st * 32 + r; const float as = ACSs[hh2 * 128 + s];
#pragma unroll
                    for (int i = 0; i < 16; ++i) { const int li = lt * 32 + crow(i, hh); float v = 0.f; if (s <= li) v = sc[k][i] * __expf(ACSs[hh2 * 128 + li] - as); PS[li * 136 + s] = (bf16_t)f2bf(v); } } }
            __syncthreads();
            { const int pt = wave & 1; f32x16 acc = zero16(); mm32(acc, CS + lt * 32 * 136, 136, ES + pt * 32 * 136, 136, 8, lane);
#pragma unroll
                for (int i = 0; i < 16; ++i) acc[i] *= __expf(ACSs[hh2 * 128 + lt * 32 + crow(i, hh)]);
                mm32(acc, PS + lt * 32 * 136, 136, XT + pt * 32 * 136, 136, 2 * (lt + 1), lane);
                const float Dh = a.ssm_D[l * 4 + head];
#pragma unroll
                for (int i = 0; i < 16; ++i) { const int li = lt * 32 + crow(i, hh); acc[i] += Dh * bf2f(xbc[(size_t)(t0 + li) * 768 + head * 64 + pt * 32 + r]); }
                y[hh2] = acc; }
            __syncthreads();
        }
        { const int pt = wave & 1;
#pragma unroll
            for (int hh2 = 0; hh2 < 2; ++hh2)
#pragma unroll
                for (int i = 0; i < 16; ++i) { const int li = lt * 32 + crow(i, hh), ch = hh2 * 64 + pt * 32 + r; const float z = bf2f(proj[(size_t)(t0 + li) * PLD + C_SZ + g * 128 + ch]);
                    Y[li * 132 + ch] = y[hh2][i] * siluf(z); } }
        __syncthreads();
        { const int li = tid >> 2, part = tid & 3; const LAS float* yr = Y + li * 132 + part * 32; float v[32]; float ss = 0.f;
#pragma unroll
            for (int e = 0; e < 32; ++e) { v[e] = yr[e]; ss += v[e] * v[e]; }
            ss += shx(ss, 1, lane); ss += shx(ss, 2, lane); const float ri = rsqrtf(ss * (1.f / 128) + EPS);
            const float* nwp = a.ssm_norm + l * 256 + g * 128 + part * 32; bf16_t* op = mix + (size_t)(t0 + li) * DM + 768 + g * 128 + part * 32; float nw[32];
#pragma unroll
            for (int q = 0; q < 8; ++q) { const f32x4 n4 = *(const f32x4*)(nwp + 4 * q); nw[4 * q] = n4[0]; nw[4 * q + 1] = n4[1]; nw[4 * q + 2] = n4[2]; nw[4 * q + 3] = n4[3]; }
#pragma unroll
            for (int q = 0; q < 4; ++q) { u32x4 o;
#pragma unroll
                for (int e = 0; e < 4; ++e) o[e] = cvtpk(v[q * 8 + 2 * e] * ri * nw[q * 8 + 2 * e], v[q * 8 + 2 * e + 1] * ri * nw[q * 8 + 2 * e + 1]);
                *(u32x4*)(op + q * 8) = o; } }
        __syncthreads();
    }
}

template <int OFF> DI void lds_rd128(u32x4& dst, unsigned addr) { asm volatile("ds_read_b128 %0, %1 offset:%2" : "=&v"(dst) : "v"(addr), "n"(OFF)); }
template <int NS, int KP, int... I> DI void lds_rd_k(u32x4 (&kf)[2 * NS], unsigned base, std::integer_sequence<int, I...>) { (lds_rd128<((I / NS) * 32 * KP + 16 * (I % NS)) * 2>(kf[I], base), ...); }
template <int... I> DI void lds_rd_v(u32x4 (&vf)[8], unsigned base, std::integer_sequence<int, I...>) { (lds_rd128<((I & 1) * 32 * 72 + (I >> 2) * 32 + 16 * ((I >> 1) & 1)) * 2>(vf[I], base), ...); }
template <int DK, bool BIAS>
DI void attn_tile(const LAS unsigned char* st, const bf16x8 (&qf)[DK / 16], float fq, bool diag, int key0, int qrow, f32x16& o0, f32x16& o1, float& mref, float& lsum, int r, int h, int lane) {
    constexpr int KP = DK + 8, VOFF = 64 * KP * 2, FOFF = VOFF + 64 * 72 * 2, NS = DK / 16;
    const LAS float* Fs = (const LAS float*)(st + FOFF);
    const unsigned stb = (unsigned)(uintptr_t)st; const unsigned kbase = stb + (unsigned)((r * KP + 8 * h) * 2), vbase = stb + (unsigned)(VOFF + (r * 72 + 8 * h) * 2);
    u32x4 kf[2 * NS];
    lds_rd_k<NS, KP>(kf, kbase, std::make_integer_sequence<int, 2 * NS>{});
    f32x16 p[2];
    const float cinit = fq - mref;
    const bool zinit = !BIAS && (__builtin_amdgcn_ballot_w64(mref != 0.f) == 0ull);
    if (!zinit) {
#pragma unroll
        for (int kb = 0; kb < 2; ++kb) {
            if (BIAS) {
#pragma unroll
                for (int g = 0; g < 4; ++g) { const f32x4 fk = *(const LAS f32x4*)(Fs + kb * 32 + 8 * g + 4 * h);
#pragma unroll
                    for (int e = 0; e < 4; ++e) p[kb][4 * g + e] = cinit - fk[e]; }
            } else {
#pragma unroll
                for (int i = 0; i < 16; ++i) p[kb][i] = cinit; }
        }
    }
    if (NS == 4) asm volatile("s_waitcnt lgkmcnt(0)" : "+v"(kf[0]), "+v"(kf[1]), "+v"(kf[2]), "+v"(kf[3]), "+v"(kf[4]), "+v"(kf[5]), "+v"(kf[6]), "+v"(kf[7]));
    else asm volatile("s_waitcnt lgkmcnt(0)" : "+v"(kf[0]), "+v"(kf[1]), "+v"(kf[2]), "+v"(kf[3]), "+v"(kf[4]), "+v"(kf[5]), "+v"(kf[6]), "+v"(kf[7]), "+v"(kf[2 * NS - 4]), "+v"(kf[2 * NS - 3]), "+v"(kf[2 * NS - 2]), "+v"(kf[2 * NS - 1]));
    __builtin_amdgcn_s_setprio(1);
    if (zinit) {
        p[0] = MFMA32(__builtin_bit_cast(bf16x8, kf[0]), qf[0], zero16());
        p[1] = MFMA32(__builtin_bit_cast(bf16x8, kf[NS]), qf[0], zero16());
#pragma unroll
        for (int s = 1; s < NS; ++s) {
            p[0] = MFMA32(__builtin_bit_cast(bf16x8, kf[s]), qf[s], p[0]);
            p[1] = MFMA32(__builtin_bit_cast(bf16x8, kf[NS + s]), qf[s], p[1]); }
    } else {
#pragma unroll
        for (int s = 0; s < NS; ++s) {
            p[0] = MFMA32(__builtin_bit_cast(bf16x8, kf[s]), qf[s], p[0]);
            p[1] = MFMA32(__builtin_bit_cast(bf16x8, kf[NS + s]), qf[s], p[1]); }
    }
    __builtin_amdgcn_s_setprio(0);
    u32x4 vf[8];
    lds_rd_v(vf, vbase, std::make_integer_sequence<int, 8>{});
    if (diag) {
#pragma unroll
        for (int kb = 0; kb < 2; ++kb)
#pragma unroll
            for (int i = 0; i < 16; ++i) if (key0 + kb * 32 + crow(i, h) > qrow) p[kb][i] = -INFINITY;
    }
    float mx = p[0][0];
#pragma unroll
    for (int i = 1; i < 16; ++i) mx = fmaxf(mx, p[0][i]);
#pragma unroll
    for (int i = 0; i < 16; ++i) mx = fmaxf(mx, p[1][i]);
    mx = fmaxf(mx, shx(mx, 32, lane));
    if (__builtin_amdgcn_ballot_w64(mx > (BIAS ? 6.0f : 20.0f)) != 0ull) {
        const float delta = fmaxf(mx, 0.f), alpha = __builtin_amdgcn_exp2f(-delta);
#pragma unroll
        for (int kb = 0; kb < 2; ++kb)
#pragma unroll
            for (int i = 0; i < 16; ++i) p[kb][i] -= delta;
#pragma unroll
        for (int i = 0; i < 16; ++i) { o0[i] *= alpha; o1[i] *= alpha; }
        lsum *= alpha; mref += delta;
    }
    float ps = 0.f;
#pragma unroll
    for (int kb = 0; kb < 2; ++kb)
#pragma unroll
        for (int i = 0; i < 16; ++i) { p[kb][i] = __builtin_amdgcn_exp2f(p[kb][i]); ps += p[kb][i]; }
    lsum += ps;
    asm volatile("s_waitcnt lgkmcnt(0)" : "+v"(vf[0]), "+v"(vf[1]), "+v"(vf[2]), "+v"(vf[3]), "+v"(vf[4]), "+v"(vf[5]), "+v"(vf[6]), "+v"(vf[7]));
#pragma unroll
    for (int kb = 0; kb < 2; ++kb)
#pragma unroll
        for (int s = 0; s < 2; ++s) { const bf16x8 pb = pack8(p[kb][8 * s], p[kb][8 * s + 1], p[kb][8 * s + 2], p[kb][8 * s + 3], p[kb][8 * s + 4], p[kb][8 * s + 5], p[kb][8 * s + 6], p[kb][8 * s + 7]);
            o0 = MFMA32(__builtin_bit_cast(bf16x8, vf[kb * 4 + s * 2]), pb, o0);
            o1 = MFMA32(__builtin_bit_cast(bf16x8, vf[kb * 4 + s * 2 + 1]), pb, o1); }
}
template <int DK, bool BIAS>
DI void attn_unit(LAS unsigned char* lds, const bf16_t* Q, int ldq, const bf16_t* K, int ldk, const bf16_t* Vt, const float* F, bf16_t* O, int ldo, int qb, int tid, float qkb) {
    constexpr int KP = DK + 8, KBYTES = 64 * KP * 2, VOFF = KBYTES, FOFF = VOFF + 64 * 72 * 2, STAGE = FOFF + 256, CPR = DK / 8, NCH = 64 * CPR;
    const int w = __builtin_amdgcn_readfirstlane(tid >> 6), lane = tid & 63, r = lane & 31, h = lane >> 5;
    const int q0 = qb * 256, qrow = q0 + 32 * w + r;
    bf16x8 qf[DK / 16];
#pragma unroll
    for (int s = 0; s < DK / 16; ++s) qf[s] = *(const bf16x8*)(Q + (size_t)qrow * ldq + 16 * s + 8 * h);
    const float fq = BIAS ? F[qrow] : 0.f;
    f32x16 o0 = zero16(), o1 = zero16(); float mref = 0.f, lsum = 0.f;
    const int ntiles = 4 * qb + 4, my_last = 4 * qb + (w >> 1);
    const int krow0 = tid / CPR, kch0 = tid % CPR, krow1 = (tid + 512) / CPR, kch1 = (tid + 512) % CPR; const bool k2 = (NCH > 512) && (tid + 512 < NCH);
    const int vrow = tid >> 3, vch = tid & 7;
    u32x4 kr0, kr1 = (u32x4){0u, 0u, 0u, 0u}, vr; float fr = 0.f;
    __syncthreads();
    int tstart = 0;
    if (BIAS) {
        LAS int* tsh = (LAS int*)(lds + 2 * STAGE);
        const bool need = (tid < ntiles) && (F[q0] - F[64 * tid + 63] + qkb >= -160.f);
        const unsigned long long bal = __builtin_amdgcn_ballot_w64(need);
        if (w < 2 && lane == 0) tsh[w] = bal ? (64 * w + (int)__builtin_ctzll(bal)) : (ntiles - 1);
        __syncthreads();
        tstart = min(min(tsh[0], tsh[1]), ntiles - 1);
        __syncthreads();
    }
    { const int key0 = tstart * 64;
        kr0 = *(const u32x4*)(K + (size_t)(key0 + krow0) * ldk + kch0 * 8); if (k2) kr1 = *(const u32x4*)(K + (size_t)(key0 + krow1) * ldk + kch1 * 8);
        vr = *(const u32x4*)(Vt + (size_t)vrow * SEQ + key0 + vch * 8); if (BIAS && tid < 64) fr = F[key0 + tid]; }
    { LAS unsigned char* st = lds + (tstart & 1) * STAGE; *(LAS u32x4*)(st + (krow0 * KP + kch0 * 8) * 2) = kr0; if (k2) *(LAS u32x4*)(st + (krow1 * KP + kch1 * 8) * 2) = kr1;
        { LAS unsigned char* vb = st + VOFF + (vrow * 72 + 16 * (vch >> 1) + 4 * (vch & 1)) * 2; *(LAS u32x2*)vb = (u32x2){vr.x, vr.y}; *(LAS u32x2*)(vb + 16) = (u32x2){vr.z, vr.w}; } if (BIAS && tid < 64) *(LAS float*)(st + FOFF + tid * 4) = fr; }
    __syncthreads();
    for (int t = tstart; t < ntiles; ++t) {
        const bool more = (t + 1 < ntiles);
        if (more) { const int key0 = (t + 1) * 64;
            kr0 = *(const u32x4*)(K + (size_t)(key0 + krow0) * ldk + kch0 * 8); if (k2) kr1 = *(const u32x4*)(K + (size_t)(key0 + krow1) * ldk + kch1 * 8);
            vr = *(const u32x4*)(Vt + (size_t)vrow * SEQ + key0 + vch * 8); if (BIAS && tid < 64) fr = F[key0 + tid]; }
        if (t <= my_last) attn_tile<DK, BIAS>(lds + (t & 1) * STAGE, qf, fq, t * 64 + 63 > q0 + 32 * w, t * 64, qrow, o0, o1, mref, lsum, r, h, lane);
        if (more) { LAS unsigned char* st = lds + ((t + 1) & 1) * STAGE; *(LAS u32x4*)(st + (krow0 * KP + kch0 * 8) * 2) = kr0; if (k2) *(LAS u32x4*)(st + (krow1 * KP + kch1 * 8) * 2) = kr1;
            { LAS unsigned char* vb = st + VOFF + (vrow * 72 + 16 * (vch >> 1) + 4 * (vch & 1)) * 2; *(LAS u32x2*)vb = (u32x2){vr.x, vr.y}; *(LAS u32x2*)(vb + 16) = (u32x2){vr.z, vr.w}; } if (BIAS && tid < 64) *(LAS float*)(st + FOFF + tid * 4) = fr; }
        __syncthreads();
    }
    const float lt = lsum + shx(lsum, 32, lane), inv = 1.f / lt;
    bf16_t* op = O + (size_t)qrow * ldo;
#pragma unroll
    for (int g = 0; g < 4; ++g) { const int dv = 8 * g + 4 * h;
        u32x2 w0; w0.x = cvtpk(o0[4 * g] * inv, o0[4 * g + 1] * inv); w0.y = cvtpk(o0[4 * g + 2] * inv, o0[4 * g + 3] * inv); *(u32x2*)(op + dv) = w0;
        u32x2 w1; w1.x = cvtpk(o1[4 * g] * inv, o1[4 * g + 1] * inv); w1.y = cvtpk(o1[4 * g + 2] * inv, o1[4 * g + 3] * inv); *(u32x2*)(op + 32 + dv) = w1; }
}
DI void phase_attn(const Args& a, int l, LAS unsigned char* lds, int tid_in) {
    int tid = tid_in;
    unsigned char* ws = a.ws; const bf16_t* proj = (const bf16_t*)(ws + WS_PROJ); bf16_t* mix = (bf16_t*)(ws + WS_HM);
    const bf16_t* qm = (const bf16_t*)(ws + WS_QM); const bf16_t* km = (const bf16_t*)(ws + WS_KM); const bf16_t* vtm = (const bf16_t*)(ws + WS_VTM); const bf16_t* vtf = (const bf16_t*)(ws + WS_VTF);
    const float* F = (const float*)(ws + WS_F); const float* qkn = (const float*)(ws + WS_CTR + 256) + l * 32; unsigned* uctr = (unsigned*)(ws + WS_CTR + 512) + l;
    LAS int* ush = (LAS int*)(lds + 140 * 1024); unsigned* done = (unsigned*)(ws + WS_CTR + 512) + 2 + l; bool p4ok = false;
    for (;;) {   LAUNDER_V(tid);
        __syncthreads();
        if (tid == 0) *ush = (int)__hip_atomic_fetch_add(uctr, 1u, __ATOMIC_RELAXED, __HIP_MEMORY_SCOPE_AGENT);
        __syncthreads();
        const int nconv = (l + 1 < DEPTH) ? (CONV_IL + 7) / 8 : 0;
        int u = *ush; if (u >= 256 + 2048 + nconv) break;
        if (u < 256) {
            phase_gla2(a, tid, u); phase_ssd2(a, tid, u); phase_mla_post(a, lds, tid, u);
            __syncthreads();
            if (tid == 0) { __builtin_amdgcn_fence(__ATOMIC_RELEASE, "agent"); __hip_atomic_fetch_add(done, 1u, __ATOMIC_RELAXED, __HIP_MEMORY_SCOPE_AGENT); }
            continue;
        }
        u -= 256;
        if (u >= 512 && !p4ok) {
            if (tid == 0) { while (__hip_atomic_load(done, __ATOMIC_RELAXED, __HIP_MEMORY_SCOPE_AGENT) < 256u) __builtin_amdgcn_s_sleep(2); __builtin_amdgcn_fence(__ATOMIC_ACQUIRE, "agent"); }
            __syncthreads(); p4ok = true;
        }
        if (u >= 2048) { const int ci = u - 2048, ib = (l + 1) * CONV_IL + ci * 8, ie = min(ib + 8, (l + 2) * CONV_IL); phase_convert(a, lds, tid >> 6, 8, tid >> 6, tid & 63, ib, ie); continue; }
        if (u >= 1536) { phase_ssd3(a, l, lds, tid, u - 1536, 1 << 20); continue; }
        if (u >= 1024) { phase_gla3(a, l, lds, tid, u - 1024, 1 << 20); continue; }
        const int type = u >> 9, v = u & 511, qb = 31 - (v >> 4), bh = v & 15, b = bh >> 2, h = bh & 3; const size_t tb = (size_t)b * SEQ;
        if (type == 1) attn_unit<96, false>(lds, qm + tb * 384 + h * 96, 384, km + tb * 384 + h * 96, 384, vtm + (size_t)bh * 64 * SEQ, nullptr, mix + tb * DM + 512 + h * 64, DM, qb, tid, 0.f);
        else attn_unit<64, true>(lds, proj + tb * PLD + C_FQ + h * 64, PLD, proj + tb * PLD + C_FK + h * 64, PLD, vtf + (size_t)bh * 64 * SEQ, F + (size_t)bh * SEQ, mix + tb * DM + h * 64, DM, qb, tid, sqrtf(qkn[bh] * qkn[16 + bh]));
    }
}
DI unsigned xcc_id() { return (unsigned)__builtin_amdgcn_s_getreg((3 << 11) | 20) & 0xFu; }
DI void grid_bar(unsigned* ctl, unsigned k, unsigned xcc, unsigned nloc, unsigned nx, int tid) {
    __syncthreads();
    if (tid == 0) {
        const unsigned old = __hip_atomic_fetch_add(ctl + 208 + xcc, 1u, __ATOMIC_RELAXED, __HIP_MEMORY_SCOPE_AGENT);
        if (old + 1 == nloc * k) {
            __builtin_amdgcn_fence(__ATOMIC_RELEASE, "agent");
            __hip_atomic_fetch_add(ctl, 1u, __ATOMIC_RELAXED, __HIP_MEMORY_SCOPE_AGENT);
        }
        while (__hip_atomic_load(ctl, __ATOMIC_RELAXED, __HIP_MEMORY_SCOPE_AGENT) < nx * k) __builtin_amdgcn_s_sleep(1);
        __builtin_amdgcn_fence(__ATOMIC_ACQUIRE, "agent");
    }
    __syncthreads();
}
DI void launder_all(int& tid, unsigned char*& ws) { asm volatile("" : "+v"(tid)); asm volatile("" : "+s"(ws)); }
__global__ void __launch_bounds__(512, 2) mk_fwd(Args a) {
    extern __shared__ __attribute__((aligned(16))) unsigned char lds_raw[];
    LAS unsigned char* lds = (LAS unsigned char*)lds_raw;
    int tid = threadIdx.x; const int G = gridDim.x, NGW = G * 8;
    unsigned char* ws = a.ws;
#define wave (tid >> 6)
#define lane (tid & 63)
#define gw ((int)blockIdx.x * 8 + wave)
#define HM ((bf16_t*)(ws + WS_HM))
#define PROJ ((bf16_t*)(ws + WS_PROJ))
    int ph = 0;
    unsigned nbar = 0, xcc = 0, nloc = 1, nx = 1;
#if MK_COOP
    cg::grid_group grid = cg::this_grid();
    unsigned* ctl = (unsigned*)(ws + WS_CTR);
    if (a.ph_hi - a.ph_lo > 1) { xcc = xcc_id(); if (tid == 0) __hip_atomic_fetch_add(ctl + 192 + xcc, 1u, __ATOMIC_RELAXED, __HIP_MEMORY_SCOPE_AGENT); }
#define SEAM() do { ++ph; if (a.ph_hi - a.ph_lo > 1) { if (ph == 1) { grid.sync(); nloc = __hip_atomic_load(ctl + 192 + xcc, __ATOMIC_RELAXED, __HIP_MEMORY_SCOPE_AGENT); nx = 0; \
            for (int j = 0; j < 16; ++j) nx += (__hip_atomic_load(ctl + 192 + j, __ATOMIC_RELAXED, __HIP_MEMORY_SCOPE_AGENT) != 0u); } \
        else { ++nbar; grid_bar(ctl, nbar, xcc, nloc, nx, tid); } } else __syncthreads(); } while (0)
#else
#define SEAM() do { ++ph; __syncthreads(); } while (0)
#endif
#define IN() (launder_all(tid, ws), (ph >= a.ph_lo && ph < a.ph_hi))
    if (IN()) { phase_convert(a, lds, gw, NGW, wave, lane, 0, CONV_IL);   phase_x_to_bf16(a.x, HM, (float*)(ws + WS_SSA), gw, NGW, lane); }
    SEAM();
    for (int l = 0; l < DEPTH; ++l) {
        unsigned char* wl = ws + WS_W + (size_t)l * W_LAYER;
        bf16_t* XA = (bf16_t*)a.out;
        if (IN()) { pg8::Gemm g{(l == 0) ? (const bf16_t*)HM : (const bf16_t*)XA, (const bf16_t*)(wl + WO_IN), T, PLD, DM, DM, DM}; pg8::StaticOrder S; S.init(T, PLD, G, blockIdx.x);
            pg8::EpiProj E{PROJ, (float*)(ws + WS_AUX), (const float*)(ws + WS_SSA)}; pg8::gemm_phase(lds, g, S, E, tid); }
        SEAM();
        if (IN()) phase_prep(a, l, lds, tid);
        SEAM();
        if (IN()) {
            { pg8::Gemm g{PROJ + C_MCQ, (const bf16_t*)(wl + WO_UQ), T, 512, 256, PLD, 256}; pg8::StaticOrder S; S.init(T, 512, G, blockIdx.x);
                pg8::EpiScale E{(bf16_t*)(ws + WS_QM), 384, (const float*)(ws + WS_RQ), 384}; pg8::gemm_phase(lds, g, S, E, tid); }
            { pg8::Gemm g{PROJ + C_MCKV, (const bf16_t*)(wl + WO_UKV), T, 512, 128, PLD, 128}; pg8::StaticOrder S; S.init(T, 512, G, blockIdx.x);
                pg8::EpiScale E{(bf16_t*)a.out + (size_t)T * DM, 512, (const float*)(ws + WS_RKV), 512}; pg8::gemm_phase(lds, g, S, E, tid); }
            phase_gla1(a, lds, tid); phase_ssd1(a, lds, tid);
        }
        SEAM();
        if (IN()) phase_attn(a, l, lds, tid);
        SEAM();
        if (IN()) { pg8::Gemm g{HM, (const bf16_t*)(wl + WO_OUT), T, DM, DM, DM, DM}; pg8::StaticOrder S; S.init(T, DM, G, blockIdx.x);
            pg8::EpiResid E{(l == 0) ? (const void*)a.x : (const void*)XA, (l == 0) ? 0 : 1, (bf16_t*)(ws + WS_XB2), (float*)(ws + WS_SSB)}; pg8::gemm_phase(lds, g, S, E, tid); }
        SEAM();
        if (IN()) { pg8::Gemm g{(const bf16_t*)(ws + WS_XB2), (const bf16_t*)(wl + WO_GU), T, 2 * FF, DM, DM, DM}; pg8::StaticOrder S; S.init(T, 2 * FF, G, blockIdx.x);
            pg8::EpiSwiglu E{PROJ, (const float*)(ws + WS_SSB)}; pg8::gemm_phase(lds, g, S, E, tid); }
        SEAM();
        if (IN()) { pg8::Gemm g{PROJ, (const bf16_t*)(wl + WO_D), T, DM, FF, FF, FF}; pg8::StaticOrder S; S.init(T, DM, G, blockIdx.x);
            pg8::EpiResid E{(const void*)(ws + WS_XB2), 1, (l + 1 < DEPTH) ? XA : (bf16_t*)HM, (float*)(ws + WS_SSA)}; pg8::gemm_phase(lds, g, S, E, tid); }
        SEAM();
    }
    if (IN()) phase_final_norm(HM, a.out, a.final_norm, (const float*)(ws + WS_SSA), gw, NGW, lane);
}
constexpr int N_PHASES = 2 + DEPTH * 7;

extern "C" void kernel_launch(void* const* d_in, const int* in_sizes, int n_in, void* d_out, int out_size, void* d_ws, size_t ws_size, hipStream_t stream) {
    static int grid = 0;
    if (grid == 0) {
        int dev = 0, cus = 0, per_cu = 0;
        hipGetDevice(&dev); hipDeviceGetAttribute(&cus, hipDeviceAttributeMultiprocessorCount, dev);
        hipFuncSetAttribute((const void*)mk_fwd, hipFuncAttributeMaxDynamicSharedMemorySize, LDS_BYTES);
        hipOccupancyMaxActiveBlocksPerMultiprocessor(&per_cu, (const void*)mk_fwd, 512, LDS_BYTES);
        if (per_cu < 1) per_cu = 1;
        grid = cus * per_cu; if (grid > 256) grid = 256;
        if (ws_size < WS_END) { fprintf(stderr, "ws too small: %zu < %zu\n", ws_size, (size_t)WS_END); }
        (void)hipGetLastError();
    }
    Args a{};
    a.x = (const float*)d_in[0]; a.pos = (const int*)d_in[1]; a.norm1 = (const float*)d_in[2]; a.w_in = (const float*)d_in[3]; a.fox_b = (const float*)d_in[4];
    a.gla_w2 = (const float*)d_in[5]; a.gla_b = (const float*)d_in[6]; a.gla_on = (const float*)d_in[7]; a.mla_qn = (const float*)d_in[8]; a.mla_wuq = (const float*)d_in[9];
    a.mla_kvn = (const float*)d_in[10]; a.mla_wukv = (const float*)d_in[11]; a.conv_w = (const float*)d_in[12]; a.conv_b = (const float*)d_in[13]; a.dt_bias = (const float*)d_in[14];
    a.A_log = (const float*)d_in[15]; a.ssm_D = (const float*)d_in[16]; a.ssm_norm = (const float*)d_in[17]; a.w_out = (const float*)d_in[18]; a.norm2 = (const float*)d_in[19];
    a.w_gate = (const float*)d_in[20]; a.w_up = (const float*)d_in[21]; a.w_down = (const float*)d_in[22]; a.final_norm = (const float*)d_in[23];
    a.out = (float*)d_out; a.ws = (unsigned char*)d_ws;
#if MK_COOP
    a.ph_lo = 0; a.ph_hi = N_PHASES;
    (void)hipMemsetAsync((unsigned char*)d_ws + WS_CTR, 0, 1024, stream);
    void* args[] = {&a};
    hipError_t e = hipLaunchCooperativeKernel((const void*)mk_fwd, dim3(grid), dim3(512), args, LDS_BYTES, stream);
    if (e != hipSuccess) fprintf(stderr, "cooperative launch failed: %s (grid %d)\n", hipGetErrorString(e), grid);
#else
    for (int p = 0; p < N_PHASES; ++p) { a.ph_lo = p; a.ph_hi = p + 1; hipLaunchKernelGGL(mk_fwd, dim3(grid), dim3(512), LDS_BYTES, stream, a); }
#endif
}
```

```cpp
#include <hip/hip_runtime.h>
#include <hip/hip_cooperative_groups.h>
#include <cstdio>
#include <cstdint>
#include <utility>
namespace cg = cooperative_groups;

#ifndef PROBE
#define PROBE 0
#endif
#ifndef MK_COOP
#define MK_COOP 1
#endif

#define DI __device__ __forceinline__
#define LAS __attribute__((address_space(3)))
#define GAS __attribute__((address_space(1)))
typedef unsigned short bf16_t;
typedef short bf16x8 __attribute__((ext_vector_type(8)));
typedef short s16x4 __attribute__((ext_vector_type(4)));
typedef float f32x4 __attribute__((ext_vector_type(4)));
typedef float f32x16 __attribute__((ext_vector_type(16)));
typedef unsigned u32x4 __attribute__((ext_vector_type(4)));
typedef unsigned u32x2 __attribute__((ext_vector_type(2)));
typedef __bf16 bf16x2_t __attribute__((ext_vector_type(2)));
typedef float f32x2_t __attribute__((ext_vector_type(2)));
#define MFMA32(a, b, c) __builtin_amdgcn_mfma_f32_32x32x16_bf16((a), (b), (c), 0, 0, 0)

constexpr int NB = 4, SEQ = 8192, T = NB * SEQ, DM = 1024, FF = 2816, DEPTH = 2;
constexpr int PLD = 3072;
constexpr int C_FQ = 0, C_FK = 256, C_FV = 512, C_GQ = 768, C_GK = 896, C_GV = 1024, C_GR = 1280, C_MCQ = 1536, C_MCKV = 1792, C_MKR = 1920,
              C_GG = 1952, C_FF = 1968, C_DT = 1972, C_SZ = 2048, C_XBC = 2304;
constexpr float EPS = 1e-6f, LOG2E = 1.4426950408889634f;

constexpr size_t MiB = 1u << 20;
constexpr size_t WS_W = 0, W_LAYER = 25 * MiB;
constexpr size_t WO_IN = 0, WO_OUT = 6 * MiB, WO_GU = 8 * MiB, WO_D = 19 * MiB, WO_UQ = 24 * MiB + 512 * 1024, WO_UKV = 24 * MiB + 768 * 1024;
constexpr size_t WS_XB2 = 310 * MiB;
constexpr size_t WS_HM = 50 * MiB, WS_PROJ = 114 * MiB, WS_AUX = 306 * MiB, WS_QM = 310 * MiB, WS_KM = 334 * MiB, WS_VTM = 358 * MiB, WS_VTF = 374 * MiB,
                 WS_G = 390 * MiB, WS_GS = 406 * MiB, WS_XBC = 422 * MiB, WS_SST = 470 * MiB, WS_MISC = 502 * MiB;
constexpr size_t WS_F = WS_MISC, WS_DT = WS_MISC + 512 * 1024, WS_ACS = WS_MISC + 1024 * 1024, WS_RQ = WS_MISC + 1536 * 1024, WS_RKV = WS_RQ + 128 * 1024,
                 WS_GDEC = WS_RKV + 128 * 1024, WS_ROPE = WS_MISC + 2 * MiB, WS_CTR = WS_ROPE + 4 * MiB, WS_SSA = WS_CTR + 4096, WS_SSB = WS_SSA + 128 * 1024, WS_END = WS_SSB + 128 * 1024;
static_assert(WS_END <= 512 * MiB, "ws map");

constexpr int LDS_BYTES = 144 * 1024;

DI unsigned f2bf(float f) { unsigned u = __builtin_bit_cast(unsigned, f); return (u + 0x7fffu + ((u >> 16) & 1u)) >> 16; }
DI float bf2f(unsigned short b) { return __builtin_bit_cast(float, (unsigned)b << 16); }
DI unsigned cvtpk(float lo, float hi) { f32x2_t v = {lo, hi}; bf16x2_t b = __builtin_convertvector(v, bf16x2_t); return __builtin_bit_cast(unsigned, b); }
DI float bflo(unsigned u) { return __builtin_bit_cast(float, u << 16); }
DI float bfhi(unsigned u) { return __builtin_bit_cast(float, u & 0xffff0000u); }
DI int crow(int r, int hi) { return (r & 3) + 8 * (r >> 2) + 4 * hi; }
DI float shx(float v, int m, int lane) { return __builtin_bit_cast(float, __builtin_amdgcn_ds_bpermute((lane ^ m) << 2, __builtin_bit_cast(int, v))); }
DI float wave_sum(float v, int lane) {
#pragma unroll
    for (int o = 1; o < 64; o <<= 1) v += shx(v, o, lane);
    return v;
}
DI float logsigmoidf(float z) { return fminf(z, 0.f) - __logf(1.f + __expf(-fabsf(z))); }
DI float softplusf(float z) { return fmaxf(z, 0.f) + __logf(1.f + __expf(-fabsf(z))); }
DI float siluf(float z) { return z * __builtin_amdgcn_rcpf(1.f + __expf(-z)); }
DI bf16x8 pack8(float a0, float a1, float a2, float a3, float a4, float a5, float a6, float a7) {
    u32x4 p; p.x = cvtpk(a0, a1); p.y = cvtpk(a2, a3); p.z = cvtpk(a4, a5); p.w = cvtpk(a6, a7); return __builtin_bit_cast(bf16x8, p);
}
DI void mm32(f32x16& acc, const LAS bf16_t* A, int lda, const LAS bf16_t* Bt, int ldb, int ksteps, int lane) {
    const int r = lane & 31, h = lane >> 5;
    const LAS bf16_t* ap = A + r * lda + 8 * h; const LAS bf16_t* bp = Bt + r * ldb + 8 * h;
    for (int s = 0; s < ksteps; ++s) {
        bf16x8 a = *(const LAS bf16x8*)(ap + 16 * s); bf16x8 b = *(const LAS bf16x8*)(bp + 16 * s);
        acc = MFMA32(a, b, acc);
    }
}
#define LAUNDER_V(x) asm volatile("" : "+v"(x))
#define LAUNDER_S(x) asm volatile("" : "+s"(x))
DI f32x16 zero16() { f32x16 z; for (int i = 0; i < 16; ++i) z[i] = 0.f; return z; }

namespace pg8 {
constexpr int BM = 256, BK = 64, HALF = 128, HTB = HALF * BK * 2, NXCD = 8, WGM = 8;
__host__ __device__ __forceinline__ int lds_byte(int r, int c) { const int st = (r >> 4) * 2 + (c >> 5), rr = r & 15, cc = c & 31, ob = rr * 64 + cc * 2; return st * 1024 + (ob ^ (((ob >> 9) & 1) << 5)); }
__host__ __device__ __forceinline__ void stage_rc(int b, int& R, int& C) { const int st = b / 1024, sb = b % 1024, swz = sb ^ (((sb >> 9) & 1) << 5); R = (st >> 1) * 16 + swz / 64; C = (st & 1) * 32 + (swz % 64) / 2; }
__host__ __device__ __forceinline__ int perm32(int rho) { const int n = rho >> 4, i = rho & 15; return 8 * (i >> 2) + 4 * n + (i & 3); }
struct Unit { int pm, pn; };
struct Gemm { const bf16_t* A; const bf16_t* Bt; int M, N, K, lda, ldb; };
struct StaticOrder {
    int nM, nN, nwg, G, c;
    __device__ void init(int M, int N, int G_, int c_) { nM = M / BM; nN = N / BM; nwg = nM * nN; G = G_; c = c_; }
    __device__ bool next(int i, Unit& u) const {
        const long L = (long)i * G + c; if (L >= nwg) return false;
        int wgid = (int)L; { const int q = nwg / NXCD, r = nwg % NXCD, xcd = wgid % NXCD, off = wgid / NXCD; wgid = (xcd < r ? xcd * (q + 1) : r * (q + 1) + (xcd - r) * q) + off; }
        const int nig = WGM * nN, gid = wgid / nig, fm = gid * WGM, gsz = (nM - fm) < WGM ? (nM - fm) : WGM;
        u.pm = fm + ((wgid % nig) % gsz); u.pn = (wgid % nig) / gsz; return true;
    }
};
template <class Epi>
__device__ __forceinline__ void gemm_phase(LAS unsigned char* lds, const Gemm g, const StaticOrder& S, const Epi& E, int tid) {
    LAUNDER_V(tid); const int wid = __builtin_amdgcn_readfirstlane(tid >> 6), lane = tid & 63, wr = wid >> 2, wc = wid & 3, fr = lane & 15, fq = lane >> 4;
    int K = g.K, lda = g.lda, ldb = g.ldb; LAUNDER_S(K); LAUNDER_S(lda); LAUNDER_S(ldb); const int nt = K / BK;
    unsigned voffA[2], voffB[2];
#pragma unroll
    for (int i = 0; i < 2; ++i) { int R, C; stage_rc(tid * 16 + i * 8192, R, C); const int Rb = (R & ~31) + perm32(R & 31);
        voffA[i] = (unsigned)(R * lda + C) * 2u; voffB[i] = (unsigned)(Rb * ldb + C) * 2u; }
    const size_t kstep = (size_t)(BK * 2);
    const size_t hstepA = (size_t)HALF * lda * 2, hstepB = (size_t)HALF * ldb * 2;
    const size_t tstepA = 2 * hstepA, tstepB = 2 * hstepB;
    const unsigned ldsw = (unsigned)wid * 1024u;
    const int aoff = lds_byte(wr * 64 + fr, fq * 8), boff = lds_byte(wc * 32 + fr, fq * 8);
#define PG8_SA(b, h) (((b) * 2 + (h)) * HTB)
#define PG8_SB(b, h) ((4 + (b) * 2 + (h)) * HTB)
#define PG8_STAGE(bufoff, gbase, voff) do { _Pragma("unroll") for (int _i = 0; _i < 2; ++_i) \
        __builtin_amdgcn_global_load_lds((const unsigned*)((const char*)(gbase) + (voff)[_i]), (LAS unsigned*)(lds + (bufoff) + ldsw + _i * 8192), 16, 0, 0); } while (0)
#define PG8_LDA(dst, b, h) do { _Pragma("unroll") for (int m = 0; m < 4; ++m) _Pragma("unroll") for (int k = 0; k < 2; ++k) dst[m][k] = *(const LAS bf16x8*)(lds + PG8_SA(b, h) + aoff + m * 2048 + k * 1024); } while (0)
#define PG8_LDB(dst, b, h) do { _Pragma("unroll") for (int n = 0; n < 2; ++n) _Pragma("unroll") for (int k = 0; k < 2; ++k) dst[n][k] = *(const LAS bf16x8*)(lds + PG8_SB(b, h) + boff + n * 2048 + k * 1024); } while (0)
#define PG8_MMA(ai, bj, At, Bt) do { __builtin_amdgcn_s_setprio(1); _Pragma("unroll") for (int m = 0; m < 4; ++m) _Pragma("unroll") for (int n = 0; n < 2; ++n) _Pragma("unroll") for (int k = 0; k < 2; ++k) \
        acc[ai][bj][m][n] = __builtin_amdgcn_mfma_f32_16x16x32_bf16(Bt[n][k], At[m][k], acc[ai][bj][m][n], 0, 0, 0); __builtin_amdgcn_s_setprio(0); } while (0)
#define PG8_WAIT_V(n) asm volatile("s_waitcnt vmcnt(" #n ")" ::: "memory")
#define PG8_WAIT_L(n) asm volatile("s_waitcnt lgkmcnt(" #n ")" ::: "memory")
#define PG8_BAR __builtin_amdgcn_s_barrier()
#define PG8_SCHED __builtin_amdgcn_sched_barrier(0)
    Unit cur, nxt; int ui = 0;
    if (!S.next(0, cur)) return;
    f32x4 acc[2][2][4][2];
#pragma unroll
    for (int a = 0; a < 2; ++a)
#pragma unroll
        for (int b = 0; b < 2; ++b)
#pragma unroll
            for (int m = 0; m < 4; ++m)
#pragma unroll
                for (int n = 0; n < 2; ++n) acc[a][b][m][n] = (f32x4){0.f, 0.f, 0.f, 0.f};
    bf16x8 At[4][2], B0[2][2], B1[2][2];
    const char* cA = (const char*)g.A + (size_t)cur.pm * tstepA; const char* cB = (const char*)g.Bt + (size_t)cur.pn * tstepB;
    PG8_STAGE(PG8_SB(0, 0), cB, voffB); PG8_STAGE(PG8_SB(0, 1), cB + hstepB, voffB); PG8_STAGE(PG8_SA(0, 0), cA, voffA); PG8_STAGE(PG8_SA(0, 1), cA + hstepA, voffA);
    if (wr == 1) PG8_BAR;
    PG8_WAIT_V(2); PG8_BAR;
    PG8_STAGE(PG8_SB(1, 0), cB + kstep, voffB); PG8_STAGE(PG8_SA(1, 0), cA + kstep, voffA); PG8_STAGE(PG8_SB(1, 1), cB + hstepB + kstep, voffB);
    PG8_WAIT_V(6); PG8_BAR;
    for (;;) {
        const bool has_next = S.next(ui + 1, nxt);
        const char* nA = has_next ? (const char*)g.A + (size_t)nxt.pm * tstepA : cA; const char* nB = has_next ? (const char*)g.Bt + (size_t)nxt.pn * tstepB : cB;
        for (int t = 0; t < nt; t += 2) {
            const bool last = (t == nt - 2);
            const char* a1 = cA + (size_t)(t + 1) * kstep;
            const char* a2 = last ? nA : cA + (size_t)(t + 2) * kstep; const char* b2 = last ? nB : cB + (size_t)(t + 2) * kstep;
            const char* a3 = a2 + kstep; const char* b3 = b2 + kstep;
            PG8_LDB(B0, 0, 0); PG8_LDB(B1, 0, 1); PG8_SCHED; PG8_LDA(At, 0, 0); PG8_STAGE(PG8_SA(1, 1), a1 + hstepA, voffA);
            PG8_WAIT_V(8); PG8_WAIT_L(0); PG8_BAR; PG8_MMA(0, 0, At, B0); PG8_MMA(0, 1, At, B1); PG8_BAR; PG8_SCHED;
            PG8_LDA(At, 0, 1); PG8_STAGE(PG8_SB(0, 0), b2, voffB); PG8_STAGE(PG8_SB(0, 1), b2 + hstepB, voffB); PG8_STAGE(PG8_SA(0, 0), a2, voffA);
            PG8_WAIT_V(8); PG8_WAIT_L(0); PG8_BAR; PG8_MMA(1, 0, At, B0); PG8_MMA(1, 1, At, B1); PG8_BAR; PG8_SCHED;
            PG8_LDB(B0, 1, 0); PG8_LDB(B1, 1, 1); PG8_SCHED; PG8_LDA(At, 1, 0); PG8_STAGE(PG8_SA(0, 1), a2 + hstepA, voffA);
            PG8_WAIT_V(8); PG8_WAIT_L(0); PG8_BAR; PG8_MMA(0, 0, At, B0); PG8_MMA(0, 1, At, B1); PG8_BAR; PG8_SCHED;
            PG8_LDA(At, 1, 1); PG8_STAGE(PG8_SB(1, 0), b3, voffB); PG8_STAGE(PG8_SB(1, 1), b3 + hstepB, voffB); PG8_STAGE(PG8_SA(1, 0), a3, voffA);
            PG8_WAIT_V(8); PG8_WAIT_L(0); PG8_BAR; PG8_MMA(1, 0, At, B0); PG8_MMA(1, 1, At, B1); PG8_BAR; PG8_SCHED;
        }
        if (wr == 0) PG8_BAR;
        E(acc, cur, wr, wc, fr, fq);
        if (!has_next) break;
#pragma unroll
        for (int a = 0; a < 2; ++a)
#pragma unroll
            for (int b = 0; b < 2; ++b)
#pragma unroll
                for (int m = 0; m < 4; ++m)
#pragma unroll
                    for (int n = 0; n < 2; ++n) acc[a][b][m][n] = (f32x4){0.f, 0.f, 0.f, 0.f};
        cur = nxt; cA = nA; cB = nB; ++ui;
        if (wr == 1) PG8_BAR;
    }
    PG8_WAIT_V(0);
    PG8_BAR;
#undef PG8_SA
#undef PG8_SB
#undef PG8_STAGE
#undef PG8_LDA
#undef PG8_LDB
#undef PG8_MMA
#undef PG8_WAIT_V
#undef PG8_WAIT_L
#undef PG8_BAR
#undef PG8_SCHED
}
typedef const f32x4 (&AccRef)[2][2][4][2];
DI u32x4 pk8(f32x4 v0, f32x4 v1) { u32x4 w; w.x = cvtpk(v0[0], v0[1]); w.y = cvtpk(v0[2], v0[3]); w.z = cvtpk(v1[0], v1[1]); w.w = cvtpk(v1[2], v1[3]); return w; }

struct EpiProj {
    bf16_t* O; float* aux; const float* ss;
    DI void operator()(AccRef acc, const Unit& u, int wr, int wc, int fr, int fq) const {
        const int row0 = u.pm * BM + wr * 64 + fr, col0 = u.pn * BM + wc * 32 + 8 * fq;
        float ri[2][4];
#pragma unroll
        for (int ai = 0; ai < 2; ++ai)
#pragma unroll
            for (int m = 0; m < 4; ++m) ri[ai][m] = *(const GAS float*)(ss + row0 + ai * HALF + m * 16);
#pragma unroll
        for (int ai = 0; ai < 2; ++ai)
#pragma unroll
            for (int m = 0; m < 4; ++m) ri[ai][m] = rsqrtf(ri[ai][m] * (1.f / DM) + EPS);
#pragma unroll
        for (int ai = 0; ai < 2; ++ai)
#pragma unroll
            for (int m = 0; m < 4; ++m) { const int row = row0 + ai * HALF + m * 16; bf16_t* rowp = O + (size_t)row * PLD + col0; const float r1 = ri[ai][m];
#pragma unroll
                for (int bj = 0; bj < 2; ++bj) { const f32x4 v0 = acc[ai][bj][m][0] * r1, v1 = acc[ai][bj][m][1] * r1; *(u32x4*)(rowp + bj * HALF) = pk8(v0, v1);
                    if (bj == 1 && u.pn == 7 && wc == 1) { float* ap = aux + (size_t)row * 32 + 8 * fq; *(f32x4*)ap = v0; *(f32x4*)(ap + 4) = v1; } } }
    }
};
struct EpiResid {
    const void* src; int srcbf; bf16_t* dst; float* ss;
    DI void tail(const u32x4 (&pk)[2], size_t ro, int row, int lane, int fq) const {
        float sq = 0.f;
#pragma unroll
        for (int bj = 0; bj < 2; ++bj) { *(GAS u32x4*)(dst + ro + bj * HALF) = pk[bj];
#pragma unroll
            for (int e = 0; e < 4; ++e) sq += bflo(pk[bj][e]) * bflo(pk[bj][e]) + bfhi(pk[bj][e]) * bfhi(pk[bj][e]); }
        sq += shx(sq, 16, lane); sq += shx(sq, 32, lane);
        if (fq == 0) __hip_atomic_fetch_add((GAS float*)(ss + row), sq, __ATOMIC_RELAXED, __HIP_MEMORY_SCOPE_AGENT);
    }
    DI void operator()(AccRef acc, const Unit& u, int wr, int wc, int fr, int fq) const {
        const int row0 = u.pm * BM + wr * 64 + fr, col0 = u.pn * BM + wc * 32 + 8 * fq; const int lane = fr + 16 * fq;
        if (srcbf) {
#pragma unroll
            for (int ai = 0; ai < 2; ++ai) { u32x4 sv[4][2];
#pragma unroll
                for (int m = 0; m < 4; ++m)
#pragma unroll
                    for (int bj = 0; bj < 2; ++bj) sv[m][bj] = *(const GAS u32x4*)((const bf16_t*)src + (size_t)(row0 + ai * HALF + m * 16) * DM + col0 + bj * HALF);
#pragma unroll
                for (int m = 0; m < 4; ++m) { const int row = row0 + ai * HALF + m * 16; const size_t ro = (size_t)row * DM + col0; u32x4 pk[2];
#pragma unroll
                    for (int bj = 0; bj < 2; ++bj) { const u32x4 v = sv[m][bj];
                        pk[bj] = pk8((f32x4){bflo(v.x), bfhi(v.x), bflo(v.y), bfhi(v.y)} + acc[ai][bj][m][0], (f32x4){bflo(v.z), bfhi(v.z), bflo(v.w), bfhi(v.w)} + acc[ai][bj][m][1]); }
                    tail(pk, ro, row, lane, fq); } }
        } else {
#pragma unroll
            for (int ai = 0; ai < 2; ++ai) { f32x4 sf[4][2][2];
#pragma unroll
                for (int m = 0; m < 4; ++m)
#pragma unroll
                    for (int bj = 0; bj < 2; ++bj) { const float* sp = (const float*)src + (size_t)(row0 + ai * HALF + m * 16) * DM + col0 + bj * HALF; sf[m][bj][0] = *(const GAS f32x4*)sp; sf[m][bj][1] = *(const GAS f32x4*)(sp + 4); }
#pragma unroll
                for (int m = 0; m < 4; ++m) { const int row = row0 + ai * HALF + m * 16; const size_t ro = (size_t)row * DM + col0; u32x4 pk[2];
#pragma unroll
                    for (int bj = 0; bj < 2; ++bj) pk[bj] = pk8(sf[m][bj][0] + acc[ai][bj][m][0], sf[m][bj][1] + acc[ai][bj][m][1]);
                    tail(pk, ro, row, lane, fq); } }
        }
    }
};
struct EpiSwiglu {
    bf16_t* O; const float* ss;
    DI void operator()(AccRef acc, const Unit& u, int wr, int wc, int fr, int fq) const {
        const int row0 = u.pm * BM + wr * 64 + fr, col0 = (u.pn * BM + wc * 32 + 8 * fq) >> 1;
        float ri[2][4];
#pragma unroll
        for (int ai = 0; ai < 2; ++ai)
#pragma unroll
            for (int m = 0; m < 4; ++m) ri[ai][m] = *(const GAS float*)(ss + row0 + ai * HALF + m * 16);
#pragma unroll
        for (int ai = 0; ai < 2; ++ai)
#pragma unroll
            for (int m = 0; m < 4; ++m) ri[ai][m] = rsqrtf(ri[ai][m] * (1.f / DM) + EPS);
#pragma unroll
        for (int ai = 0; ai < 2; ++ai)
#pragma unroll
            for (int m = 0; m < 4; ++m) { const int row = row0 + ai * HALF + m * 16; bf16_t* rowp = O + (size_t)row * FF + col0; const float r1 = ri[ai][m];
#pragma unroll
                for (int bj = 0; bj < 2; ++bj) { const f32x4 v0 = acc[ai][bj][m][0] * r1, v1 = acc[ai][bj][m][1] * r1;
                    u32x2 w; w.x = cvtpk(siluf(v0[0]) * v0[1], siluf(v0[2]) * v0[3]); w.y = cvtpk(siluf(v1[0]) * v1[1], siluf(v1[2]) * v1[3]);
                    *(u32x2*)(rowp + bj * (HALF / 2)) = w; } }
    }
};
struct EpiScale {
    bf16_t* O; int ldo; const float* rs; int ncols;
    DI void operator()(AccRef acc, const Unit& u, int wr, int wc, int fr, int fq) const {
        const int row0 = u.pm * BM + wr * 64 + fr, col0 = u.pn * BM + wc * 32 + 8 * fq;
        float ri[2][4];
#pragma unroll
        for (int ai = 0; ai < 2; ++ai)
#pragma unroll
            for (int m = 0; m < 4; ++m) ri[ai][m] = *(const GAS float*)(rs + row0 + ai * HALF + m * 16);
#pragma unroll
        for (int ai = 0; ai < 2; ++ai)
#pragma unroll
            for (int m = 0; m < 4; ++m) { const int row = row0 + ai * HALF + m * 16; const float r1 = ri[ai][m]; bf16_t* rowp = O + (size_t)row * ldo + col0;
#pragma unroll
                for (int bj = 0; bj < 2; ++bj) if (col0 + bj * HALF < ncols) *(u32x4*)(rowp + bj * HALF) = pk8(acc[ai][bj][m][0] * r1, acc[ai][bj][m][1] * r1); }
    }
};
}

struct Args {
    const float* x; const int* pos; const float* norm1; const float* w_in; const float* fox_b; const float* gla_w2; const float* gla_b; const float* gla_on;
    const float* mla_qn; const float* mla_wuq; const float* mla_kvn; const float* mla_wukv; const float* conv_w; const float* conv_b; const float* dt_bias;
    const float* A_log; const float* ssm_D; const float* ssm_norm; const float* w_out; const float* norm2; const float* w_gate; const float* w_up;
    const float* w_down; const float* final_norm;
    float* out; unsigned char* ws; int ph_lo, ph_hi;
};

template <int MAP> DI void wmap(const Args& a, int l, int n, const float*& W, int& ldw, int& col, float& sc) {
    sc = 1.f; col = -1; W = nullptr; ldw = 0;
    if (MAP == 0) {
        W = a.w_in + (size_t)l * DM * 3000; ldw = 3000;
        if (n < 256) { col = n; sc = 0.125f * LOG2E; }
        else if (n < 768) col = n;
        else if (n < 896) { col = 772 + (n - 768); sc = 0.17677669529663687f; }
        else if (n < 1024) col = 900 + (n - 896);
        else if (n < 1280) col = 1028 + (n - 1024);
        else if (n < 1536) col = 1284 + (n - 1280);
        else if (n < 1792) col = 1556 + (n - 1536);
        else if (n < 1920) col = 1812 + (n - 1792);
        else if (n < 1952) { const int jj = n - 1920; col = 1940 + (jj >> 1) + 16 * (jj & 1); }
        else if (n < 1968) col = 1540 + (n - 1952);
        else if (n < 1972) col = 768 + (n - 1968);
        else if (n < 1976) col = 2996 + (n - 1972);
        else if (n < 2048) col = -1;
        else if (n < 2304) col = 1972 + (n - 2048);
        else col = 2228 + (n - 2304);
    } else if (MAP == 1) { W = a.w_out + (size_t)l * DM * DM; ldw = DM; col = n; }
    else if (MAP == 2) { W = ((n & 1) ? a.w_up : a.w_gate) + (size_t)l * DM * FF; ldw = FF; col = n >> 1; }
    else if (MAP == 3) { W = a.w_down + (size_t)l * FF * DM; ldw = DM; col = n; }
    else if (MAP == 4) { W = a.mla_wuq + (size_t)l * 256 * 384; ldw = 384; sc = 0.10206207261596577f * LOG2E;
        if (n < 384) { const int head = n / 96, c = n % 96; if (c < 64) col = head * 96 + c; else { const int jj = c - 64; col = head * 96 + 64 + (jj >> 1) + 16 * (jj & 1); } } }
    else { W = a.mla_wukv + (size_t)l * 128 * 512; ldw = 512;
        if (n < 256) col = (n >> 6) * 128 + (n & 63); else col = ((n - 256) >> 6) * 128 + 64 + (n & 63); }
}
template <int MAP> DI void conv_item(const Args& a, int l, const float* gain, bf16_t* dst, int K, int nblk, int item, LAS float* scr, int lane) {
    const int kb = item / nblk, nb = item % nblk, k0 = 64 * kb, n0 = 32 * nb;
    const float* W; int ldw, col; float sc; wmap<MAP>(a, l, n0 + (lane & 31), W, ldw, col, sc);
#pragma unroll
    for (int i = 0; i < 32; ++i) { const int kk = 2 * i + (lane >> 5); float v = 0.f; if (col >= 0) v = *(const GAS float*)(W + (size_t)(k0 + kk) * ldw + col) * sc; if (gain) v *= *(const GAS float*)(gain + k0 + kk); scr[kk * 33 + (lane & 31)] = v; }
    __builtin_amdgcn_fence(__ATOMIC_RELEASE, "wavefront"); __builtin_amdgcn_wave_barrier(); __builtin_amdgcn_fence(__ATOMIC_ACQUIRE, "wavefront");
    const int c = lane & 7;
#pragma unroll
    for (int j = 0; j < 4; ++j) { const int n = (lane >> 3) + 8 * j; const LAS float* s = scr + (8 * c) * 33 + n;
        u32x4 o; o.x = cvtpk(s[0 * 33], s[1 * 33]); o.y = cvtpk(s[2 * 33], s[3 * 33]); o.z = cvtpk(s[4 * 33], s[5 * 33]); o.w = cvtpk(s[6 * 33], s[7 * 33]);
        *(u32x4*)(dst + (size_t)(n0 + n) * K + k0 + 8 * c) = o; }
    __builtin_amdgcn_fence(__ATOMIC_RELEASE, "wavefront"); __builtin_amdgcn_wave_barrier(); __builtin_amdgcn_fence(__ATOMIC_ACQUIRE, "wavefront");
}
constexpr int CONV_IL = 16 * 96 + 16 * 32 + 16 * 176 + 44 * 32 + 4 * 16 + 2 * 16;
DI void phase_convert(const Args& a, LAS unsigned char* lds, int gw, int NGW, int wave, int lane, int it_begin, int it_end) {
    LAS float* scr = (LAS float*)(lds + wave * 8704);
    constexpr int I0 = 16 * 96, I1 = 16 * 32, I2 = 16 * 176, I3 = 44 * 32, I4 = 4 * 16, I5 = 2 * 16, IL = I0 + I1 + I2 + I3 + I4 + I5;
    static_assert(IL == CONV_IL, "items per layer");
    for (int it = it_begin + gw; it < it_end; it += NGW) {
        const int l = it / IL; int r = it % IL; unsigned char* wl = a.ws + WS_W + (size_t)l * W_LAYER;
        if (r < I0) { conv_item<0>(a, l, a.norm1 + l * DM, (bf16_t*)(wl + WO_IN), DM, 96, r, scr, lane); continue; } r -= I0;
        if (r < I1) { conv_item<1>(a, l, nullptr, (bf16_t*)(wl + WO_OUT), DM, 32, r, scr, lane); continue; } r -= I1;
        if (r < I2) { conv_item<2>(a, l, a.norm2 + l * DM, (bf16_t*)(wl + WO_GU), DM, 176, r, scr, lane); continue; } r -= I2;
        if (r < I3) { conv_item<3>(a, l, nullptr, (bf16_t*)(wl + WO_D), FF, 32, r, scr, lane); continue; } r -= I3;
        if (r < I4) { conv_item<4>(a, l, a.mla_qn + l * 256, (bf16_t*)(wl + WO_UQ), 256, 16, r, scr, lane); continue; } r -= I4;
        conv_item<5>(a, l, a.mla_kvn + l * 128, (bf16_t*)(wl + WO_UKV), 128, 16, r, scr, lane);
    }
}
DI void phase_x_to_bf16(const float* X, bf16_t* H, float* ss, int gw, int NGW, int lane) {
    for (int m0 = gw * 4; m0 < T; m0 += NGW * 4) {
        f32x4 v[4][4];
#pragma unroll
        for (int q = 0; q < 4; ++q) { const f32x4* xr = (const f32x4*)(X + (size_t)(m0 + q) * DM) + lane;
#pragma unroll
            for (int j = 0; j < 4; ++j) v[q][j] = xr[64 * j]; }
#pragma unroll
        for (int q = 0; q < 4; ++q) { float s = 0.f;
#pragma unroll
            for (int j = 0; j < 4; ++j) s += (v[q][j].x * v[q][j].x + v[q][j].y * v[q][j].y) + (v[q][j].z * v[q][j].z + v[q][j].w * v[q][j].w);
            s = wave_sum(s, lane); if (lane == 0) ss[m0 + q] = s;
            u32x2* o = (u32x2*)(H + (size_t)(m0 + q) * DM) + lane;
#pragma unroll
            for (int j = 0; j < 4; ++j) { u32x2 w; w.x = cvtpk(v[q][j].x, v[q][j].y); w.y = cvtpk(v[q][j].z, v[q][j].w); o[64 * j] = w; } }
    }
}
DI void phase_final_norm(const bf16_t* X, float* out, const float* gain, const float* ss, int gw, int NGW, int lane) {
    f32x4 g[4];
#pragma unroll
    for (int j = 0; j < 4; ++j) g[j] = ((const f32x4*)gain)[lane + 64 * j];
    for (int m0 = gw * 4; m0 < T; m0 += NGW * 4) {
        u32x2 v[4][4]; float ri[4];
#pragma unroll
        for (int q = 0; q < 4; ++q) { const u32x2* xr = (const u32x2*)(X + (size_t)(m0 + q) * DM) + lane; ri[q] = ss[m0 + q];
#pragma unroll
            for (int j = 0; j < 4; ++j) v[q][j] = xr[64 * j]; }
#pragma unroll
        for (int q = 0; q < 4; ++q) { f32x4* orow = (f32x4*)(out + (size_t)(m0 + q) * DM) + lane; const float r1 = rsqrtf(ri[q] * (1.f / DM) + EPS);
#pragma unroll
            for (int j = 0; j < 4; ++j) orow[64 * j] = (f32x4){bflo(v[q][j].x) * r1 * g[j][0], bfhi(v[q][j].x) * r1 * g[j][1], bflo(v[q][j].y) * r1 * g[j][2], bfhi(v[q][j].y) * r1 * g[j][3]}; }
    }
}
DI void transpose_tile(const bf16_t* src, int ld, bf16_t* dst, LAS bf16_t* scr, int lane) {
#pragma unroll
    for (int i = 0; i < 8; ++i) { const int row = i * 8 + (lane >> 3), ch = lane & 7;
        const u32x4 v = *(const u32x4*)(src + (size_t)row * ld + ch * 8);
        LAS unsigned* d = (LAS unsigned*)(scr + row * 66 + ch * 8); d[0] = v.x; d[1] = v.y; d[2] = v.z; d[3] = v.w; }
    __builtin_amdgcn_fence(__ATOMIC_RELEASE, "wavefront"); __builtin_amdgcn_wave_barrier(); __builtin_amdgcn_fence(__ATOMIC_ACQUIRE, "wavefront");
#pragma unroll
    for (int i = 0; i < 8; ++i) { const int dv = i * 8 + (lane >> 3), ch = lane & 7; const LAS bf16_t* sp = scr + (ch * 8) * 66 + dv;
        u32x4 o; o.x = sp[0] | ((unsigned)sp[66] << 16); o.y = sp[2 * 66] | ((unsigned)sp[3 * 66] << 16); o.z = sp[4 * 66] | ((unsigned)sp[5 * 66] << 16); o.w = sp[6 * 66] | ((unsigned)sp[7 * 66] << 16);
        *(u32x4*)(dst + (size_t)dv * SEQ + ch * 8) = o; }
    __builtin_amdgcn_fence(__ATOMIC_RELEASE, "wavefront"); __builtin_amdgcn_wave_barrier(); __builtin_amdgcn_fence(__ATOMIC_ACQUIRE, "wavefront");
}
DI void phase_prep(const Args& a, int l, LAS unsigned char* lds, int tid) {
    const int wave = tid >> 6, lane = tid & 63, G = gridDim.x, gw = blockIdx.x * 8 + wave, NGW = G * 8, gws = wave * G + blockIdx.x;
    unsigned char* ws = a.ws;
    const bf16_t* proj = (const bf16_t*)(ws + WS_PROJ); const float* aux = (const float*)(ws + WS_AUX);
    { float* ssa = (float*)(ws + WS_SSA); float* ssb = (float*)(ws + WS_SSB); for (int i = blockIdx.x * 512 + tid; i < T; i += G * 512) { ssa[i] = 0.f; ssb[i] = 0.f; } }
    {
        LAS float* red = (LAS float*)(lds + 139264);
        float* F = (float*)(ws + WS_F);
        for (int bh = (G >= 256 && (blockIdx.x & 15) == 5) ? (int)(blockIdx.x >> 4) : ((G >= 256) ? 16 : (int)blockIdx.x); bh < 16; bh += G) {
            const int b = bh >> 2, h = bh & 3; const float bias = a.fox_b[l * 4 + h];
            float v[16]; float run = 0.f;
#pragma unroll
            for (int i = 0; i < 16; ++i) { const int s = tid * 16 + i; run += logsigmoidf(aux[(size_t)(b * SEQ + s) * 32 + 16 + h] + bias); v[i] = run; }
            float inc = run;
#pragma unroll
            for (int o = 1; o < 64; o <<= 1) { const float t = __builtin_bit_cast(float, __builtin_amdgcn_ds_bpermute(((lane - o) & 63) << 2, __builtin_bit_cast(int, inc))); if (lane >= o) inc += t; }
            __syncthreads();
            if (lane == 63) red[wave] = inc;
            __syncthreads();
            float base = inc - run; for (int w = 0; w < wave; ++w) base += red[w];
#pragma unroll
            for (int i = 0; i < 16; ++i) F[(size_t)bh * SEQ + tid * 16 + i] = (base + v[i]) * LOG2E;
        }
    }
    {
        LAS bf16_t* scr = (LAS bf16_t*)(lds + wave * 8704); bf16_t* vt = (bf16_t*)(ws + WS_VTF); int* qkn = (int*)(ws + WS_CTR + 256) + l * 32;
        for (int it = gw; it < 16 * 128; it += NGW) {
            const int bh = it >> 7, tile = it & 127, b = bh >> 2, h = bh & 3, s0 = tile * 64;
            const bf16_t* qp = proj + (size_t)(b * SEQ + s0) * PLD + C_FQ + h * 64; const bf16_t* kp = proj + (size_t)(b * SEQ + s0) * PLD + C_FK + h * 64;
            float qm = 0.f, km = 0.f;
#pragma unroll
            for (int i = 0; i < 8; ++i) { const int row = i * 8 + (lane >> 3), ch = lane & 7; const u32x4 qv = *(const u32x4*)(qp + (size_t)row * PLD + ch * 8), kv = *(const u32x4*)(kp + (size_t)row * PLD + ch * 8);
                float sq = 0.f, sk = 0.f;
#pragma unroll
                for (int e = 0; e < 4; ++e) { sq += bflo(qv[e]) * bflo(qv[e]) + bfhi(qv[e]) * bfhi(qv[e]); sk += bflo(kv[e]) * bflo(kv[e]) + bfhi(kv[e]) * bfhi(kv[e]); }
#pragma unroll
                for (int o = 1; o < 8; o <<= 1) { sq += shx(sq, o, lane); sk += shx(sk, o, lane); }
                qm = fmaxf(qm, sq); km = fmaxf(km, sk); }
#pragma unroll
            for (int o = 8; o < 64; o <<= 1) { qm = fmaxf(qm, shx(qm, o, lane)); km = fmaxf(km, shx(km, o, lane)); }
            if (lane == 0) { __hip_atomic_fetch_max(qkn + bh, __builtin_bit_cast(int, qm), __ATOMIC_RELAXED, __HIP_MEMORY_SCOPE_AGENT); __hip_atomic_fetch_max(qkn + 16 + bh, __builtin_bit_cast(int, km), __ATOMIC_RELAXED, __HIP_MEMORY_SCOPE_AGENT); }
            transpose_tile(proj + (size_t)(b * SEQ + s0) * PLD + C_FV + h * 64, PLD, vt + (size_t)bh * 64 * SEQ + s0, scr, lane);
        }
    }
    {
        float* rq = (float*)(ws + WS_RQ); float* rkv = (float*)(ws + WS_RKV); float* rope = (float*)(ws + WS_ROPE); bf16_t* km = (bf16_t*)(ws + WS_KM);
        const int g4 = lane >> 4, j = lane & 15; const float inv = exp2f(-(float)j * (13.287712379549449f / 16.f));
        for (int t4 = gw; t4 < T / 4; t4 += NGW) {
            const int t = t4 * 4 + g4; const bf16_t* pr = proj + (size_t)t * PLD;
            const u32x4 q0 = *(const u32x4*)(pr + C_MCQ + j * 16), q1 = *(const u32x4*)(pr + C_MCQ + j * 16 + 8), kv = *(const u32x4*)(pr + C_MCKV + j * 8);
            const unsigned kr = *(const unsigned*)(pr + C_MKR + 2 * j); const float posf = (float)a.pos[t];
            float sq = 0.f, skv = 0.f;
#pragma unroll
            for (int e = 0; e < 4; ++e) { sq += bflo(q0[e]) * bflo(q0[e]) + bfhi(q0[e]) * bfhi(q0[e]) + bflo(q1[e]) * bflo(q1[e]) + bfhi(q1[e]) * bfhi(q1[e]); skv += bflo(kv[e]) * bflo(kv[e]) + bfhi(kv[e]) * bfhi(kv[e]); }
#pragma unroll
            for (int o = 1; o < 16; o <<= 1) { sq += shx(sq, o, lane); skv += shx(skv, o, lane); }
            if (j == 0) { rq[t] = rsqrtf(sq * (1.f / 256) + EPS); rkv[t] = rsqrtf(skv * (1.f / 128) + EPS); }
            const float ang = posf * inv;
            const float k = rintf(ang * 0.15915494309189535f); float rr = fmaf(-k, 6.28125f, ang); rr = fmaf(-k, 1.9353071795864769e-3f, rr);
            const float c = __cosf(rr), sn = __sinf(rr);
            *(f32x2_t*)(rope + (size_t)t * 32 + 2 * j) = (f32x2_t){c, sn};
            const float t1 = bflo(kr), t2 = bfhi(kr);
            const unsigned o = cvtpk(t1 * c - t2 * sn, t1 * sn + t2 * c);
#pragma unroll
            for (int hh = 0; hh < 4; ++hh) *(unsigned*)(km + (size_t)t * 384 + hh * 96 + 64 + 2 * j) = o;
        }
    }
    {
        float* Gp = (float*)(ws + WS_G);
        for (int it = gws; it < 1024; it += NGW) {
            const int ch = it & 1, bc = it >> 1, col = ch * 64 + lane; const int t0 = bc * 64;
            float w2[16];
#pragma unroll
            for (int r = 0; r < 16; ++r) w2[r] = a.gla_w2[(size_t)l * 16 * 128 + r * 128 + col];
            const float b2 = a.gla_b[l * 128 + col]; float run = 0.f;
            const float* ap = aux + (size_t)(t0 + lane) * 32; float gg[16];
#pragma unroll
            for (int q = 0; q < 4; ++q) { const f32x4 g4 = *(const f32x4*)(ap + 4 * q); gg[4 * q] = g4[0]; gg[4 * q + 1] = g4[1]; gg[4 * q + 2] = g4[2]; gg[4 * q + 3] = g4[3]; }
#pragma unroll 4
            for (int i = 0; i < 64; ++i) { float z = b2;
#pragma unroll
                for (int r = 0; r < 16; ++r) z += __builtin_bit_cast(float, __builtin_amdgcn_readlane(__builtin_bit_cast(int, gg[r]), i)) * w2[r];
                run += logsigmoidf(z) * (1.f / 16.f);
                Gp[(size_t)(t0 + i) * 128 + col] = run; }
        }
    }
    {
        bf16_t* xbc = (bf16_t*)(ws + WS_XBC);
        for (int it = blockIdx.x; it < T / 32; it += G) {
            if (tid < 384) { const int cg = tid % 96, ts = tid / 96, c0 = cg * 8, t0 = it * 32 + ts * 8;
                float w[4][8], bias[8];
#pragma unroll
                for (int k = 0; k < 4; ++k)
#pragma unroll
                    for (int e = 0; e < 8; ++e) w[k][e] = a.conv_w[(size_t)l * 4 * 768 + k * 768 + c0 + e];
#pragma unroll
                for (int e = 0; e < 8; ++e) bias[e] = a.conv_b[l * 768 + c0 + e];
                u32x4 win[3];
#pragma unroll
                for (int k = 0; k < 3; ++k) { const int t = t0 - 3 + k; win[k] = (u32x4){0u, 0u, 0u, 0u}; if ((t0 & (SEQ - 1)) + k - 3 >= 0) win[k] = *(const u32x4*)(proj + (size_t)t * PLD + C_XBC + c0); }
                u32x4 rows8[8];
#pragma unroll
                for (int i = 0; i < 8; ++i) rows8[i] = *(const u32x4*)(proj + (size_t)(t0 + i) * PLD + C_XBC + c0);
#pragma unroll
                for (int i = 0; i < 8; ++i) { const int t = t0 + i; const u32x4 cur = rows8[i];
                    float o[8];
#pragma unroll
                    for (int e = 0; e < 4; ++e) {
                        o[2 * e] = bias[2 * e] + w[0][2 * e] * bflo(win[0][e]) + w[1][2 * e] * bflo(win[1][e]) + w[2][2 * e] * bflo(win[2][e]) + w[3][2 * e] * bflo(cur[e]);
                        o[2 * e + 1] = bias[2 * e + 1] + w[0][2 * e + 1] * bfhi(win[0][e]) + w[1][2 * e + 1] * bfhi(win[1][e]) + w[2][2 * e + 1] * bfhi(win[2][e]) + w[3][2 * e + 1] * bfhi(cur[e]); }
                    u32x4 ov; ov.x = cvtpk(siluf(o[0]), siluf(o[1])); ov.y = cvtpk(siluf(o[2]), siluf(o[3])); ov.z = cvtpk(siluf(o[4]), siluf(o[5])); ov.w = cvtpk(siluf(o[6]), siluf(o[7]));
                    *(u32x4*)(xbc + (size_t)t * 768 + c0) = ov;
                    win[0] = win[1]; win[1] = win[2]; win[2] = cur; }
            }
        }
    }
    {
        float* DT = (float*)(ws + WS_DT); float* ACS = (float*)(ws + WS_ACS);
        f32x4 bias, Ah;
#pragma unroll
        for (int h = 0; h < 4; ++h) { bias[h] = a.dt_bias[l * 4 + h]; Ah[h] = -__expf(a.A_log[l * 4 + h]); }
        for (int it = gws; it < 256; it += NGW) {
            const size_t t0 = (size_t)it * 128 + 2 * lane;
            const f32x4 r0 = *(const f32x4*)(aux + t0 * 32 + 20), r1 = *(const f32x4*)(aux + (t0 + 1) * 32 + 20);
            f32x4 dt0, dt1, a0, a1;
#pragma unroll
            for (int h = 0; h < 4; ++h) { dt0[h] = softplusf(r0[h] + bias[h]); dt1[h] = softplusf(r1[h] + bias[h]); a0[h] = Ah[h] * dt0[h]; a1[h] = a0[h] + Ah[h] * dt1[h]; }
            float i0 = a1[0], i1 = a1[1], i2 = a1[2], i3 = a1[3];
#pragma unroll
            for (int o = 1; o < 64; o <<= 1) { const int ad = ((lane - o) & 63) << 2; const bool up = lane >= o;
                const float t0_ = __builtin_bit_cast(float, __builtin_amdgcn_ds_bpermute(ad, __builtin_bit_cast(int, i0)));
                const float t1_ = __builtin_bit_cast(float, __builtin_amdgcn_ds_bpermute(ad, __builtin_bit_cast(int, i1)));
                const float t2_ = __builtin_bit_cast(float, __builtin_amdgcn_ds_bpermute(ad, __builtin_bit_cast(int, i2)));
                const float t3_ = __builtin_bit_cast(float, __builtin_amdgcn_ds_bpermute(ad, __builtin_bit_cast(int, i3)));
                i0 += up ? t0_ : 0.f; i1 += up ? t1_ : 0.f; i2 += up ? t2_ : 0.f; i3 += up ? t3_ : 0.f; }
            const f32x4 inc = {i0, i1, i2, i3};
            const f32x4 base = inc - a1;
            *(f32x4*)(DT + t0 * 4) = dt0; *(f32x4*)(DT + (t0 + 1) * 4) = dt1; *(f32x4*)(ACS + t0 * 4) = base + a0; *(f32x4*)(ACS + (t0 + 1) * 4) = base + a1;
        }
    }
}


DI void phase_mla_post(const Args& a, LAS unsigned char* lds, int tid, int vb) {
    const int wave = tid >> 6, lane = tid & 63, gw = vb * 8 + wave, NGW = 256 * 8; unsigned char* ws = a.ws;
    bf16_t* qm = (bf16_t*)(ws + WS_QM); bf16_t* km = (bf16_t*)(ws + WS_KM); bf16_t* vtm = (bf16_t*)(ws + WS_VTM); const bf16_t* kvraw = (const bf16_t*)a.out + (size_t)T * DM; const float* rope = (const float*)(ws + WS_ROPE);
    { const int hd = lane >> 4, j = lane & 15;
        for (int tb = gw * 4; tb < T; tb += NGW * 4) { unsigned v[4]; f32x2_t cs[4];
#pragma unroll
            for (int q = 0; q < 4; ++q) { v[q] = *(const unsigned*)(qm + (size_t)(tb + q) * 384 + hd * 96 + 64 + 2 * j); cs[q] = *(const f32x2_t*)(rope + (size_t)(tb + q) * 32 + 2 * j); }
#pragma unroll
            for (int q = 0; q < 4; ++q) { const float t1 = bflo(v[q]), t2 = bfhi(v[q]); *(unsigned*)(qm + (size_t)(tb + q) * 384 + hd * 96 + 64 + 2 * j) = cvtpk(t1 * cs[q][0] - t2 * cs[q][1], t1 * cs[q][1] + t2 * cs[q][0]); } } }
    LAS bf16_t* scr = (LAS bf16_t*)(lds + wave * 8704);
    for (int it = gw; it < 16 * 128; it += NGW) {
        const int bh = it >> 7, tile = it & 127, b = bh >> 2, h = bh & 3, s0 = tile * 64; const size_t t0 = (size_t)b * SEQ + s0;
        u32x4 kc[8];
#pragma unroll
        for (int i = 0; i < 8; ++i) { const int row = i * 8 + (lane >> 3), ch = lane & 7; kc[i] = *(const u32x4*)(kvraw + (t0 + row) * 512 + h * 64 + ch * 8); }
#pragma unroll
        for (int i = 0; i < 8; ++i) { const int row = i * 8 + (lane >> 3), ch = lane & 7; *(u32x4*)(km + (t0 + row) * 384 + h * 96 + ch * 8) = kc[i]; }
        transpose_tile(kvraw + t0 * 512 + 256 + h * 64, 512, vtm + (size_t)bh * 64 * SEQ + s0, scr, lane);
    }
}

DI void gla_stage_vt(const bf16_t* proj, int t0, int h, LAS bf16_t* VT, int u) {
    const int li = u >> 1, half = u & 1; const bf16_t* src = proj + (size_t)(t0 + li) * PLD + C_GV + h * 64 + half * 32;
#pragma unroll
    for (int q = 0; q < 4; ++q) { const u32x4 v = *(const u32x4*)(src + q * 8);
#pragma unroll
        for (int e = 0; e < 4; ++e) { VT[(half * 32 + q * 8 + 2 * e) * 72 + li] = (bf16_t)(v[e] & 0xffffu); VT[(half * 32 + q * 8 + 2 * e + 1) * 72 + li] = (bf16_t)(v[e] >> 16); } }
}
DI void phase_gla1(const Args& a, LAS unsigned char* lds, int tid) {
    const int wave = __builtin_amdgcn_readfirstlane(tid >> 6), lane = tid & 63, G = gridDim.x; unsigned char* ws = a.ws;
    const bf16_t* proj = (const bf16_t*)(ws + WS_PROJ); const float* Gp = (const float*)(ws + WS_G); float* GS = (float*)(ws + WS_GS); float* GDEC = (float*)(ws + WS_GDEC);
    constexpr int SLOT = 13824;
    for (int task = blockIdx.x; task < 512; task += G) {
        const int bh = task >> 5, c0 = (task & 31) * 4, b = bh >> 2, h = bh & 3;
        { const int cs = tid >> 7, u = tid & 127, t0 = b * SEQ + (c0 + cs) * 64; LAS bf16_t* KT = (LAS bf16_t*)(lds + cs * SLOT); LAS bf16_t* VT = KT + 32 * 72;
            const int li = u >> 1, dh = u & 1; const bf16_t* ks = proj + (size_t)(t0 + li) * PLD + C_GK + h * 32 + dh * 16; const float* gs = Gp + (size_t)(t0 + li) * 128 + h * 32 + dh * 16;
#pragma unroll
            for (int q = 0; q < 2; ++q) { const u32x4 kv = *(const u32x4*)(ks + q * 8); const f32x4 g0 = *(const f32x4*)(gs + q * 8), g1 = *(const f32x4*)(gs + q * 8 + 4);
#pragma unroll
                for (int e = 0; e < 4; ++e) { const float ga = (e < 2) ? g0[2 * e] : g1[2 * e - 4], gb = (e < 2) ? g0[2 * e + 1] : g1[2 * e - 3];
                    KT[(dh * 16 + q * 8 + 2 * e) * 72 + li] = (bf16_t)f2bf(bflo(kv[e]) * __expf(-ga)); KT[(dh * 16 + q * 8 + 2 * e + 1) * 72 + li] = (bf16_t)f2bf(bfhi(kv[e]) * __expf(-gb)); } }
            gla_stage_vt(proj, t0, h, VT, u); }
        __syncthreads();
        { const int cs = wave >> 1, mt = wave & 1, c = c0 + cs, t0 = b * SEQ + c * 64, r = lane & 31, hh = lane >> 5;
            const LAS bf16_t* KT = (const LAS bf16_t*)(lds + cs * SLOT); const LAS bf16_t* VT = KT + 32 * 72;
            f32x16 acc = zero16(); mm32(acc, VT + mt * 32 * 72, 72, KT, 72, 4, lane);
            const float dec = __expf(Gp[(size_t)(t0 + 63) * 128 + h * 32 + r]);
            float* dst = GS + ((size_t)(bh * 128 + c) * 64) * 32;
#pragma unroll
            for (int i = 0; i < 16; ++i) dst[(mt * 32 + crow(i, hh)) * 32 + r] = acc[i] * dec;
            if (mt == 0 && hh == 0) GDEC[(size_t)(bh * 128 + c) * 32 + r] = dec; }
        __syncthreads();
    }
}
DI void phase_gla2(const Args& a, int tid, int vb) {
    float* GS = (float*)(a.ws + WS_GS); const float* GDEC = (const float*)(a.ws + WS_GDEC);
    if (tid < 128) for (int idx = vb * 128 + tid; idx < 16 * 2048; idx += 256 * 128) {
        const int bh = idx >> 11, e = idx & 2047, d = e & 31; float run = 0.f;
        float locA[16], decA[16], locB[16], decB[16];
#define G2_LOAD(L, D, c0) _Pragma("unroll") for (int j = 0; j < 16; ++j) { L[j] = GS[(size_t)(bh * 128 + (c0) + j) * 2048 + e]; D[j] = GDEC[(size_t)(bh * 128 + (c0) + j) * 32 + d]; }
#define G2_PROC(L, D, c0) _Pragma("unroll") for (int j = 0; j < 16; ++j) { GS[(size_t)(bh * 128 + (c0) + j) * 2048 + e] = run; run = D[j] * run + L[j]; }
        G2_LOAD(locA, decA, 0)
        for (int c0 = 0; c0 < 128; c0 += 32) {
            G2_LOAD(locB, decB, c0 + 16)
            G2_PROC(locA, decA, c0)
            if (c0 + 32 < 128) { G2_LOAD(locA, decA, c0 + 32) }
            G2_PROC(locB, decB, c0 + 16)
        }
#undef G2_LOAD
#undef G2_PROC
    }
}
DI void phase_gla3(const Args& a, int l, LAS unsigned char* lds, int tid, int task0, int tstep) {
    const int wave = __builtin_amdgcn_readfirstlane(tid >> 6), lane = tid & 63, G = gridDim.x; unsigned char* ws = a.ws;
    const bf16_t* proj = (const bf16_t*)(ws + WS_PROJ); const float* Gp = (const float*)(ws + WS_G); const float* GS = (const float*)(ws + WS_GS); bf16_t* mix = (bf16_t*)(ws + WS_HM);
    constexpr int SLOT = 24576;
    for (int task = task0; task < 512; task += tstep) {
        const int bh = task >> 5, c0 = (task & 31) * 4, b = bh >> 2, h = bh & 3;
        { const int cs = tid >> 7, u = tid & 127, c = c0 + cs, t0 = b * SEQ + c * 64;
            LAS bf16_t* QS = (LAS bf16_t*)(lds + cs * SLOT); LAS bf16_t* KS = QS + 64 * 40; LAS bf16_t* VT = KS + 64 * 40; LAS bf16_t* SB = VT + 64 * 72;
            const int li = u >> 1, dh = u & 1; const bf16_t* qs = proj + (size_t)(t0 + li) * PLD + C_GQ + h * 32 + dh * 16; const bf16_t* ks = proj + (size_t)(t0 + li) * PLD + C_GK + h * 32 + dh * 16;
            const float* gs = Gp + (size_t)(t0 + li) * 128 + h * 32 + dh * 16;
#pragma unroll
            for (int q = 0; q < 2; ++q) { const u32x4 qv = *(const u32x4*)(qs + q * 8), kv = *(const u32x4*)(ks + q * 8); const f32x4 g0 = *(const f32x4*)(gs + q * 8), g1 = *(const f32x4*)(gs + q * 8 + 4);
                u32x4 qo, ko;
#pragma unroll
                for (int e = 0; e < 4; ++e) { const float ga = (e < 2) ? g0[2 * e] : g1[2 * e - 4], gb = (e < 2) ? g0[2 * e + 1] : g1[2 * e - 3];
                    qo[e] = cvtpk(bflo(qv[e]) * __expf(ga), bfhi(qv[e]) * __expf(gb)); ko[e] = cvtpk(bflo(kv[e]) * __expf(-ga), bfhi(kv[e]) * __expf(-gb)); }
                *(LAS u32x4*)(QS + li * 40 + dh * 16 + q * 8) = qo; *(LAS u32x4*)(KS + li * 40 + dh * 16 + q * 8) = ko; }
            gla_stage_vt(proj, t0, h, VT, u);
            { const int dv = u >> 1; const float* sp = GS + ((size_t)(bh * 128 + c) * 64 + dv) * 32 + dh * 16;
#pragma unroll
                for (int q = 0; q < 2; ++q) { const f32x4 s0 = *(const f32x4*)(sp + q * 8), s1 = *(const f32x4*)(sp + q * 8 + 4); u32x4 o; o.x = cvtpk(s0[0], s0[1]); o.y = cvtpk(s0[2], s0[3]); o.z = cvtpk(s1[0], s1[1]); o.w = cvtpk(s1[2], s1[3]);
                    *(LAS u32x4*)(SB + dv * 40 + dh * 16 + q * 8) = o; } } }
        __syncthreads();
        { const int cs = wave >> 1, it = wave & 1, c = c0 + cs, t0 = b * SEQ + c * 64, r = lane & 31, hh = lane >> 5;
            const LAS bf16_t* QS = (const LAS bf16_t*)(lds + cs * SLOT); const LAS bf16_t* KS = QS + 64 * 40; const LAS bf16_t* VT = KS + 64 * 40; const LAS bf16_t* SB = VT + 64 * 72;
            f32x16 o[2]; o[0] = zero16(); o[1] = zero16();
            mm32(o[0], SB, 40, QS + it * 32 * 40, 40, 2, lane); mm32(o[1], SB + 32 * 40, 40, QS + it * 32 * 40, 40, 2, lane);
            for (int jt = 0; jt <= it; ++jt) {
                f32x16 st = zero16(); mm32(st, KS + jt * 32 * 40, 40, QS + it * 32 * 40, 40, 2, lane);
                if (jt == it) {
#pragma unroll
                    for (int i = 0; i < 16; ++i) if (crow(i, hh) > r) st[i] = 0.f; }
#pragma unroll
                for (int s = 0; s < 2; ++s) { const bf16x8 pb = pack8(st[8 * s], st[8 * s + 1], st[8 * s + 2], st[8 * s + 3], st[8 * s + 4], st[8 * s + 5], st[8 * s + 6], st[8 * s + 7]);
#pragma unroll
                    for (int dt = 0; dt < 2; ++dt) { const LAS bf16_t* vp = VT + (dt * 32 + r) * 72 + jt * 32 + 16 * s + 4 * hh;
                        const s16x4 lo = *(const LAS s16x4*)vp, hi = *(const LAS s16x4*)(vp + 8); const bf16x8 va = __builtin_shufflevector(lo, hi, 0, 1, 2, 3, 4, 5, 6, 7);
                        o[dt] = MFMA32(va, pb, o[dt]); } }
            }
            float ss = 0.f;
#pragma unroll
            for (int i = 0; i < 16; ++i) ss += o[0][i] * o[0][i] + o[1][i] * o[1][i];
            ss += shx(ss, 32, lane); const float ri = rsqrtf(ss * (1.f / 64) + EPS);
            const int t = t0 + it * 32 + r; const bf16_t* rp = proj + (size_t)t * PLD + C_GR + h * 64; bf16_t* op = mix + (size_t)t * DM + 256 + h * 64;
            u32x2 rvs[2][4];
#pragma unroll
            for (int dt = 0; dt < 2; ++dt)
#pragma unroll
                for (int g = 0; g < 4; ++g) rvs[dt][g] = *(const u32x2*)(rp + dt * 32 + 8 * g + 4 * hh);
#pragma unroll
            for (int dt = 0; dt < 2; ++dt)
#pragma unroll
                for (int g = 0; g < 4; ++g) { const int dv = dt * 32 + 8 * g + 4 * hh; const u32x2 rv = rvs[dt][g]; const f32x4 gn = *(const f32x4*)(a.gla_on + l * 64 + dv);
                    u32x2 w; w.x = cvtpk(o[dt][4 * g] * ri * gn[0] * siluf(bflo(rv.x)), o[dt][4 * g + 1] * ri * gn[1] * siluf(bfhi(rv.x)));
                    w.y = cvtpk(o[dt][4 * g + 2] * ri * gn[2] * siluf(bflo(rv.y)), o[dt][4 * g + 3] * ri * gn[3] * siluf(bfhi(rv.y)));
                    *(u32x2*)(op + dv) = w; } }
        __syncthreads();
    }
}

DI void phase_ssd1(const Args& a, LAS unsigned char* lds, int tid) {
    const int wave = __builtin_amdgcn_readfirstlane(tid >> 6), lane = tid & 63, G = gridDim.x; unsigned char* ws = a.ws;
    const bf16_t* xbc = (const bf16_t*)(ws + WS_XBC); const float* DT = (const float*)(ws + WS_DT); const float* ACS = (const float*)(ws + WS_ACS); float* SST = (float*)(ws + WS_SST);
    LAS bf16_t* XT = (LAS bf16_t*)lds; LAS bf16_t* BT = XT + 128 * 136;
    for (int task = blockIdx.x; task < 512; task += G) {
        const int g = task & 1, bc = task >> 1, b = bc >> 6, c = bc & 63, t0 = b * SEQ + c * 128;
        { const int li = tid >> 2, qt = tid & 3, hh2 = qt >> 1, head = 2 * g + hh2, t = t0 + li;
            const float sc = DT[(size_t)t * 4 + head] * __expf(ACS[(size_t)(t0 + 127) * 4 + head] - ACS[(size_t)t * 4 + head]);
            const bf16_t* xs = xbc + (size_t)t * 768 + g * 128 + qt * 32; const bf16_t* bs = xbc + (size_t)t * 768 + 256 + g * 128 + qt * 32;
#pragma unroll
            for (int q = 0; q < 4; ++q) { const u32x4 xv = *(const u32x4*)(xs + q * 8), bv = *(const u32x4*)(bs + q * 8);
#pragma unroll
                for (int e = 0; e < 4; ++e) { const int ch = qt * 32 + q * 8 + 2 * e;
                    XT[ch * 136 + li] = (bf16_t)f2bf(bflo(xv[e]) * sc); XT[(ch + 1) * 136 + li] = (bf16_t)f2bf(bfhi(xv[e]) * sc);
                    BT[ch * 136 + li] = (bf16_t)(bv[e] & 0xffffu); BT[(ch + 1) * 136 + li] = (bf16_t)(bv[e] >> 16); } } }
        __syncthreads();
        { const int mt = wave >> 1, r = lane & 31, hh = lane >> 5;
#pragma unroll
            for (int k = 0; k < 2; ++k) { const int nt = 2 * (wave & 1) + k; f32x16 acc = zero16(); mm32(acc, XT + mt * 32 * 136, 136, BT + nt * 32 * 136, 136, 8, lane);
#pragma unroll
                for (int i = 0; i < 16; ++i) { const int hp = mt * 32 + crow(i, hh), head = 2 * g + (hp >> 6), p = hp & 63;
                    SST[(((size_t)(b * 64 + c) * 4 + head) * 64 + p) * 128 + nt * 32 + r] = acc[i]; } } }
        __syncthreads();
    }
}
DI void phase_ssd2(const Args& a, int tid, int vb) {
    float* SST = (float*)(a.ws + WS_SST); const float* ACS = (const float*)(a.ws + WS_ACS);
    for (int idx = vb * 512 + tid; idx < 4 * 32768; idx += 256 * 512) {
        const int b = idx >> 15, rem = idx & 32767, head = rem >> 13, pn = rem & 8191; float run = 0.f;
        float locA[16], decA[16], locB[16], decB[16];
#define S2_LOAD(L, D, c0) _Pragma("unroll") for (int j = 0; j < 16; ++j) { L[j] = SST[((size_t)(b * 64 + (c0) + j) * 4 + head) * 8192 + pn]; D[j] = ACS[(size_t)(b * SEQ + ((c0) + j) * 128 + 127) * 4 + head]; }
#define S2_PROC(L, D, c0) _Pragma("unroll") for (int j = 0; j < 16; ++j) { SST[((size_t)(b * 64 + (c0) + j) * 4 + head) * 8192 + pn] = run; run = __expf(D[j]) * run + L[j]; }
        S2_LOAD(locA, decA, 0)
        for (int c0 = 0; c0 < 64; c0 += 32) {
            S2_LOAD(locB, decB, c0 + 16)
            S2_PROC(locA, decA, c0)
            if (c0 + 32 < 64) { S2_LOAD(locA, decA, c0 + 32) }
            S2_PROC(locB, decB, c0 + 16)
        }
#undef S2_LOAD
#undef S2_PROC
    }
}
DI void phase_ssd3(const Args& a, int l, LAS unsigned char* lds, int tid, int task0, int tstep) {
    const int wave = __builtin_amdgcn_readfirstlane(tid >> 6), lane = tid & 63, G = gridDim.x; unsigned char* ws = a.ws;
    const bf16_t* proj = (const bf16_t*)(ws + WS_PROJ); const bf16_t* xbc = (const bf16_t*)(ws + WS_XBC); const float* DT = (const float*)(ws + WS_DT); const float* ACS = (const float*)(ws + WS_ACS);
    const float* SST = (const float*)(ws + WS_SST); bf16_t* mix = (bf16_t*)(ws + WS_HM);
    LAS bf16_t* CS = (LAS bf16_t*)lds; LAS bf16_t* BS = CS + 128 * 136; LAS bf16_t* PS = BS + 128 * 136; LAS bf16_t* XT = PS + 128 * 136; LAS bf16_t* ES = XT + 64 * 136;
    LAS float* ACSs = (LAS float*)(ES + 64 * 136); LAS float* DTs = ACSs + 256; LAS float* Y = (LAS float*)BS;
    for (int task = task0; task < 512; task += tstep) {
        const int g = task & 1, bc = task >> 1, b = bc >> 6, c = bc & 63, t0 = b * SEQ + c * 128;
#pragma unroll
        for (int i = 0; i < 4; ++i) { const int idx = tid + 512 * i, row = idx >> 4, ch = idx & 15;
            *(LAS u32x4*)(CS + row * 136 + ch * 8) = *(const u32x4*)(xbc + (size_t)(t0 + row) * 768 + 512 + g * 128 + ch * 8);
            *(LAS u32x4*)(BS + row * 136 + ch * 8) = *(const u32x4*)(xbc + (size_t)(t0 + row) * 768 + 256 + g * 128 + ch * 8); }
        if (tid < 256) { const int hh2 = tid >> 7, li = tid & 127; ACSs[tid] = ACS[(size_t)(t0 + li) * 4 + 2 * g + hh2]; DTs[tid] = DT[(size_t)(t0 + li) * 4 + 2 * g + hh2]; }
        __syncthreads();
        const int lt = wave >> 1, r = lane & 31, hh = lane >> 5;
        f32x16 sc[2];
#pragma unroll
        for (int k = 0; k < 2; ++k) { const int st = 2 * (wave & 1) + k; sc[k] = zero16(); if (st <= lt) mm32(sc[k], CS + lt * 32 * 136, 136, BS + st * 32 * 136, 136, 8, lane); }
        f32x16 y[2];
#pragma unroll
        for (int hh2 = 0; hh2 < 2; ++hh2) {
            const int head = 2 * g + hh2;
            { const int si = tid >> 2, qt = tid & 3; const float dt = DTs[hh2 * 128 + si]; const bf16_t* xs = xbc + (size_t)(t0 + si) * 768 + head * 64 + qt * 16;
#pragma unroll
                for (int q = 0; q < 2; ++q) { const u32x4 xv = *(const u32x4*)(xs + q * 8);
#pragma unroll
                    for (int e = 0; e < 4; ++e) { const int p = qt * 16 + q * 8 + 2 * e; XT[p * 136 + si] = (bf16_t)f2bf(bflo(xv[e]) * dt); XT[(p + 1) * 136 + si] = (bf16_t)f2bf(bfhi(xv[e]) * dt); } }
                const int p = tid >> 3, ch = tid & 7; const float* sp = SST + (((size_t)(b * 64 + c) * 4 + head) * 64 + p) * 128 + ch * 16;
#pragma unroll
                for (int q = 0; q < 2; ++q) { const f32x4 s0 = *(const f32x4*)(sp + q * 8), s1 = *(const f32x4*)(sp + q * 8 + 4); u32x4 o; o.x = cvtpk(s0[0], s0[1]); o.y = cvtpk(s0[2], s0[3]); o.z = cvtpk(s1[0], s1[1]); o.w = cvtpk(s1[2], s1[3]);
                    *(LAS u32x4*)(ES + p * 136 + ch * 16 + q * 8) = o; } }
#pragma unroll
            for (int k = 0; k < 2; ++k) { const int st = 2 * (wave & 1) + k; if (st <= lt) { const int s = st * 32 + r; const float as = ACSs[hh2 * 128 + s];
#pragma unroll
                    for (int i = 0; i < 16; ++i) { const int li = lt * 32 + crow(i, hh); float v = 0.f; if (s <= li) v = sc[k][i] * __expf(ACSs[hh2 * 128 + li] - as); PS[li * 136 + s] = (bf16_t)f2bf(v); } } }
            __syncthreads();
            { const int pt = wave & 1; f32x16 acc = zero16(); mm32(acc, CS + lt * 32 * 136, 136, ES + pt * 32 * 136, 136, 8, lane);
#pragma unroll
                for (int i = 0; i < 16; ++i) acc[i] *= __expf(ACSs[hh2 * 128 + lt * 32 + crow(i, hh)]);
                mm32(acc, PS + lt * 32 * 136, 136, XT + pt * 32 * 136, 136, 2 * (lt + 1), lane);
                const float Dh = a.ssm_D[l * 4 + head];
#pragma unroll
                for (int i = 0; i < 16; ++i) { const int li = lt * 32 + crow(i, hh); acc[i] += Dh * bf2f(xbc[(size_t)(t0 + li) * 768 + head * 64 + pt * 32 + r]); }
                y[hh2] = acc; }
            __syncthreads();
        }
        { const int pt = wave & 1;
#pragma unroll
            for (int hh2 = 0; hh2 < 2; ++hh2)
#pragma unroll
                for (int i = 0; i < 16; ++i) { const int li = lt * 32 + crow(i, hh), ch = hh2 * 64 + pt * 32 + r; const float z = bf2f(proj[(size_t)(t0 + li) * PLD + C_SZ + g * 128 + ch]);
                    Y[li * 132 + ch] = y[hh2][i] * siluf(z); } }
        __syncthreads();
        { const int li = tid >> 2, part = tid & 3; const LAS float* yr = Y + li * 132 + part * 32; float v[32]; float ss = 0.f;
#pragma unroll
            for (int e = 0; e < 32; ++e) { v[e] = yr[e]; ss += v[e] * v[e]; }
            ss += shx(ss, 1, lane); ss += shx(ss, 2, lane); const float ri = rsqrtf(ss * (1.f / 128) + EPS);
            const float* nw = a.ssm_norm + l * 256 + g * 128 + part * 32; bf16_t* op = mix + (size_t)(t0 + li) * DM + 768 + g * 128 + part * 32;
#pragma unroll
            for (int q = 0; q < 4; ++q) { u32x4 o;
#pragma unroll
                for (int e = 0; e < 4; ++e) o[e] = cvtpk(v[q * 8 + 2 * e] * ri * nw[q * 8 + 2 * e], v[q * 8 + 2 * e + 1] * ri * nw[q * 8 + 2 * e + 1]);
                *(u32x4*)(op + q * 8) = o; } }
        __syncthreads();
    }
}

template <int OFF> DI void lds_rd128(u32x4& dst, unsigned addr) { asm volatile("ds_read_b128 %0, %1 offset:%2" : "=&v"(dst) : "v"(addr), "n"(OFF)); }
template <int NS, int KP, int... I> DI void lds_rd_k(u32x4 (&kf)[2 * NS], unsigned base, std::integer_sequence<int, I...>) { (lds_rd128<((I / NS) * 32 * KP + 16 * (I % NS)) * 2>(kf[I], base), ...); }
template <int... I> DI void lds_rd_v(u32x4 (&vf)[8], unsigned base, std::integer_sequence<int, I...>) { (lds_rd128<((I & 1) * 32 * 72 + (I >> 2) * 32 + 16 * ((I >> 1) & 1)) * 2>(vf[I], base), ...); }
template <int DK, bool BIAS>
DI void attn_tile(const LAS unsigned char* st, const bf16x8 (&qf)[DK / 16], float fq, bool diag, int key0, int qrow, f32x16& o0, f32x16& o1, float& mref, float& lsum, int r, int h, int lane) {
    constexpr int KP = DK + 8, VOFF = 64 * KP * 2, FOFF = VOFF + 64 * 72 * 2, NS = DK / 16;
    const LAS float* Fs = (const LAS float*)(st + FOFF);
    const unsigned stb = (unsigned)(uintptr_t)st; const unsigned kbase = stb + (unsigned)((r * KP + 8 * h) * 2), vbase = stb + (unsigned)(VOFF + (r * 72 + 8 * h) * 2);
    u32x4 kf[2 * NS];
    lds_rd_k<NS, KP>(kf, kbase, std::make_integer_sequence<int, 2 * NS>{});
    f32x16 p[2];
    const float cinit = fq - mref;
    const bool zinit = !BIAS && (__builtin_amdgcn_ballot_w64(mref != 0.f) == 0ull);
    if (!zinit) {
#pragma unroll
        for (int kb = 0; kb < 2; ++kb) {
            if (BIAS) {
#pragma unroll
                for (int g = 0; g < 4; ++g) { const f32x4 fk = *(const LAS f32x4*)(Fs + kb * 32 + 8 * g + 4 * h);
#pragma unroll
                    for (int e = 0; e < 4; ++e) p[kb][4 * g + e] = cinit - fk[e]; }
            } else {
#pragma unroll
                for (int i = 0; i < 16; ++i) p[kb][i] = cinit; }
        }
    }
    if (NS == 4) asm volatile("s_waitcnt lgkmcnt(0)" : "+v"(kf[0]), "+v"(kf[1]), "+v"(kf[2]), "+v"(kf[3]), "+v"(kf[4]), "+v"(kf[5]), "+v"(kf[6]), "+v"(kf[7]));
    else asm volatile("s_waitcnt lgkmcnt(0)" : "+v"(kf[0]), "+v"(kf[1]), "+v"(kf[2]), "+v"(kf[3]), "+v"(kf[4]), "+v"(kf[5]), "+v"(kf[6]), "+v"(kf[7]), "+v"(kf[2 * NS - 4]), "+v"(kf[2 * NS - 3]), "+v"(kf[2 * NS - 2]), "+v"(kf[2 * NS - 1]));
    __builtin_amdgcn_s_setprio(1);
    if (zinit) {
        p[0] = MFMA32(__builtin_bit_cast(bf16x8, kf[0]), qf[0], zero16());
        p[1] = MFMA32(__builtin_bit_cast(bf16x8, kf[NS]), qf[0], zero16());
#pragma unroll
        for (int s = 1; s < NS; ++s) {
            p[0] = MFMA32(__builtin_bit_cast(bf16x8, kf[s]), qf[s], p[0]);
            p[1] = MFMA32(__builtin_bit_cast(bf16x8, kf[NS + s]), qf[s], p[1]); }
    } else {
#pragma unroll
        for (int s = 0; s < NS; ++s) {
            p[0] = MFMA32(__builtin_bit_cast(bf16x8, kf[s]), qf[s], p[0]);
            p[1] = MFMA32(__builtin_bit_cast(bf16x8, kf[NS + s]), qf[s], p[1]); }
    }
    __builtin_amdgcn_s_setprio(0);
    u32x4 vf[8];
    lds_rd_v(vf, vbase, std::make_integer_sequence<int, 8>{});
    if (diag) {
#pragma unroll
        for (int kb = 0; kb < 2; ++kb)
#pragma unroll
            for (int i = 0; i < 16; ++i) if (key0 + kb * 32 + crow(i, h) > qrow) p[kb][i] = -INFINITY;
    }
    float mx = p[0][0];
#pragma unroll
    for (int i = 1; i < 16; ++i) mx = fmaxf(mx, p[0][i]);
#pragma unroll
    for (int i = 0; i < 16; ++i) mx = fmaxf(mx, p[1][i]);
    mx = fmaxf(mx, shx(mx, 32, lane));
    if (__builtin_amdgcn_ballot_w64(mx > (BIAS ? 6.0f : 20.0f)) != 0ull) {
        const float delta = fmaxf(mx, 0.f), alpha = __builtin_amdgcn_exp2f(-delta);
#pragma unroll
        for (int kb = 0; kb < 2; ++kb)
#pragma unroll
            for (int i = 0; i < 16; ++i) p[kb][i] -= delta;
#pragma unroll
        for (int i = 0; i < 16; ++i) { o0[i] *= alpha; o1[i] *= alpha; }
        lsum *= alpha; mref += delta;
    }
    float ps = 0.f;
#pragma unroll
    for (int kb = 0; kb < 2; ++kb)
#pragma unroll
        for (int i = 0; i < 16; ++i) { p[kb][i] = __builtin_amdgcn_exp2f(p[kb][i]); ps += p[kb][i]; }
    lsum += ps;
    asm volatile("s_waitcnt lgkmcnt(0)" : "+v"(vf[0]), "+v"(vf[1]), "+v"(vf[2]), "+v"(vf[3]), "+v"(vf[4]), "+v"(vf[5]), "+v"(vf[6]), "+v"(vf[7]));
#pragma unroll
    for (int kb = 0; kb < 2; ++kb)
#pragma unroll
        for (int s = 0; s < 2; ++s) { const bf16x8 pb = pack8(p[kb][8 * s], p[kb][8 * s + 1], p[kb][8 * s + 2], p[kb][8 * s + 3], p[kb][8 * s + 4], p[kb][8 * s + 5], p[kb][8 * s + 6], p[kb][8 * s + 7]);
            o0 = MFMA32(__builtin_bit_cast(bf16x8, vf[kb * 4 + s * 2]), pb, o0);
            o1 = MFMA32(__builtin_bit_cast(bf16x8, vf[kb * 4 + s * 2 + 1]), pb, o1); }
}
template <int DK, bool BIAS>
DI void attn_unit(LAS unsigned char* lds, const bf16_t* Q, int ldq, const bf16_t* K, int ldk, const bf16_t* Vt, const float* F, bf16_t* O, int ldo, int qb, int tid, float qkb) {
    constexpr int KP = DK + 8, KBYTES = 64 * KP * 2, VOFF = KBYTES, FOFF = VOFF + 64 * 72 * 2, STAGE = FOFF + 256, CPR = DK / 8, NCH = 64 * CPR;
    const int w = __builtin_amdgcn_readfirstlane(tid >> 6), lane = tid & 63, r = lane & 31, h = lane >> 5;
    const int q0 = qb * 256, qrow = q0 + 32 * w + r;
    bf16x8 qf[DK / 16];
#pragma unroll
    for (int s = 0; s < DK / 16; ++s) qf[s] = *(const bf16x8*)(Q + (size_t)qrow * ldq + 16 * s + 8 * h);
    const float fq = BIAS ? F[qrow] : 0.f;
    f32x16 o0 = zero16(), o1 = zero16(); float mref = 0.f, lsum = 0.f;
    const int ntiles = 4 * qb + 4, my_last = 4 * qb + (w >> 1);
    const int krow0 = tid / CPR, kch0 = tid % CPR, krow1 = (tid + 512) / CPR, kch1 = (tid + 512) % CPR; const bool k2 = (NCH > 512) && (tid + 512 < NCH);
    const int vrow = tid >> 3, vch = tid & 7;
    u32x4 kr0, kr1 = (u32x4){0u, 0u, 0u, 0u}, vr; float fr = 0.f;
    __syncthreads();
    int tstart = 0;
    if (BIAS) {
        LAS int* tsh = (LAS int*)(lds + 2 * STAGE);
        const bool need = (tid < ntiles) && (F[q0] - F[64 * tid + 63] + qkb >= -160.f);
        const unsigned long long bal = __builtin_amdgcn_ballot_w64(need);
        if (w < 2 && lane == 0) tsh[w] = bal ? (64 * w + (int)__builtin_ctzll(bal)) : (ntiles - 1);
        __syncthreads();
        tstart = min(min(tsh[0], tsh[1]), ntiles - 1);
        __syncthreads();
    }
    { const int key0 = tstart * 64;
        kr0 = *(const u32x4*)(K + (size_t)(key0 + krow0) * ldk + kch0 * 8); if (k2) kr1 = *(const u32x4*)(K + (size_t)(key0 + krow1) * ldk + kch1 * 8);
        vr = *(const u32x4*)(Vt + (size_t)vrow * SEQ + key0 + vch * 8); if (BIAS && tid < 64) fr = F[key0 + tid]; }
    { LAS unsigned char* st = lds + (tstart & 1) * STAGE; *(LAS u32x4*)(st + (krow0 * KP + kch0 * 8) * 2) = kr0; if (k2) *(LAS u32x4*)(st + (krow1 * KP + kch1 * 8) * 2) = kr1;
        { LAS unsigned char* vb = st + VOFF + (vrow * 72 + 16 * (vch >> 1) + 4 * (vch & 1)) * 2; *(LAS u32x2*)vb = (u32x2){vr.x, vr.y}; *(LAS u32x2*)(vb + 16) = (u32x2){vr.z, vr.w}; } if (BIAS && tid < 64) *(LAS float*)(st + FOFF + tid * 4) = fr; }
    __syncthreads();
    for (int t = tstart; t < ntiles; ++t) {
        const bool more = (t + 1 < ntiles);
        if (more) { const int key0 = (t + 1) * 64;
            kr0 = *(const u32x4*)(K + (size_t)(key0 + krow0) * ldk + kch0 * 8); if (k2) kr1 = *(const u32x4*)(K + (size_t)(key0 + krow1) * ldk + kch1 * 8);
            vr = *(const u32x4*)(Vt + (size_t)vrow * SEQ + key0 + vch * 8); if (BIAS && tid < 64) fr = F[key0 + tid]; }
        if (t <= my_last) attn_tile<DK, BIAS>(lds + (t & 1) * STAGE, qf, fq, t * 64 + 63 > q0 + 32 * w, t * 64, qrow, o0, o1, mref, lsum, r, h, lane);
        if (more) { LAS unsigned char* st = lds + ((t + 1) & 1) * STAGE; *(LAS u32x4*)(st + (krow0 * KP + kch0 * 8) * 2) = kr0; if (k2) *(LAS u32x4*)(st + (krow1 * KP + kch1 * 8) * 2) = kr1;
            { LAS unsigned char* vb = st + VOFF + (vrow * 72 + 16 * (vch >> 1) + 4 * (vch & 1)) * 2; *(LAS u32x2*)vb = (u32x2){vr.x, vr.y}; *(LAS u32x2*)(vb + 16) = (u32x2){vr.z, vr.w}; } if (BIAS && tid < 64) *(LAS float*)(st + FOFF + tid * 4) = fr; }
        __syncthreads();
    }
    const float lt = lsum + shx(lsum, 32, lane), inv = 1.f / lt;
    bf16_t* op = O + (size_t)qrow * ldo;
#pragma unroll
    for (int g = 0; g < 4; ++g) { const int dv = 8 * g + 4 * h;
        u32x2 w0; w0.x = cvtpk(o0[4 * g] * inv, o0[4 * g + 1] * inv); w0.y = cvtpk(o0[4 * g + 2] * inv, o0[4 * g + 3] * inv); *(u32x2*)(op + dv) = w0;
        u32x2 w1; w1.x = cvtpk(o1[4 * g] * inv, o1[4 * g + 1] * inv); w1.y = cvtpk(o1[4 * g + 2] * inv, o1[4 * g + 3] * inv); *(u32x2*)(op + 32 + dv) = w1; }
}
DI void phase_attn(const Args& a, int l, LAS unsigned char* lds, int tid_in) {
    int tid = tid_in;
    unsigned char* ws = a.ws; const bf16_t* proj = (const bf16_t*)(ws + WS_PROJ); bf16_t* mix = (bf16_t*)(ws + WS_HM);
    const bf16_t* qm = (const bf16_t*)(ws + WS_QM); const bf16_t* km = (const bf16_t*)(ws + WS_KM); const bf16_t* vtm = (const bf16_t*)(ws + WS_VTM); const bf16_t* vtf = (const bf16_t*)(ws + WS_VTF);
    const float* F = (const float*)(ws + WS_F); const float* qkn = (const float*)(ws + WS_CTR + 256) + l * 32; unsigned* uctr = (unsigned*)(ws + WS_CTR + 512) + l;
    LAS int* ush = (LAS int*)(lds + 140 * 1024); unsigned* done = (unsigned*)(ws + WS_CTR + 512) + 2 + l; bool p4ok = false;
    for (;;) {   LAUNDER_V(tid);
        __syncthreads();
        if (tid == 0) *ush = (int)__hip_atomic_fetch_add(uctr, 1u, __ATOMIC_RELAXED, __HIP_MEMORY_SCOPE_AGENT);
        __syncthreads();
        const int nconv = (l + 1 < DEPTH) ? (CONV_IL + 7) / 8 : 0;
        int u = *ush; if (u >= 256 + 2048 + nconv) break;
        if (u < 256) {
            phase_gla2(a, tid, u); phase_ssd2(a, tid, u); phase_mla_post(a, lds, tid, u);
            __syncthreads();
            if (tid == 0) { __builtin_amdgcn_fence(__ATOMIC_RELEASE, "agent"); __hip_atomic_fetch_add(done, 1u, __ATOMIC_RELAXED, __HIP_MEMORY_SCOPE_AGENT); }
            continue;
        }
        u -= 256;
        if (u >= 512 && !p4ok) {
            if (tid == 0) { while (__hip_atomic_load(done, __ATOMIC_RELAXED, __HIP_MEMORY_SCOPE_AGENT) < 256u) __builtin_amdgcn_s_sleep(2); __builtin_amdgcn_fence(__ATOMIC_ACQUIRE, "agent"); }
            __syncthreads(); p4ok = true;
        }
        if (u >= 2048) { const int ci = u - 2048, ib = (l + 1) * CONV_IL + ci * 8, ie = min(ib + 8, (l + 2) * CONV_IL); phase_convert(a, lds, tid >> 6, 8, tid >> 6, tid & 63, ib, ie); continue; }
        if (u >= 1536) { phase_ssd3(a, l, lds, tid, u - 1536, 1 << 20); continue; }
        if (u >= 1024) { phase_gla3(a, l, lds, tid, u - 1024, 1 << 20); continue; }
        const int type = u >> 9, v = u & 511, qb = 31 - (v >> 4), bh = v & 15, b = bh >> 2, h = bh & 3; const size_t tb = (size_t)b * SEQ;
        if (type == 1) attn_unit<96, false>(lds, qm + tb * 384 + h * 96, 384, km + tb * 384 + h * 96, 384, vtm + (size_t)bh * 64 * SEQ, nullptr, mix + tb * DM + 512 + h * 64, DM, qb, tid, 0.f);
        else attn_unit<64, true>(lds, proj + tb * PLD + C_FQ + h * 64, PLD, proj + tb * PLD + C_FK + h * 64, PLD, vtf + (size_t)bh * 64 * SEQ, F + (size_t)bh * SEQ, mix + tb * DM + h * 64, DM, qb, tid, sqrtf(qkn[bh] * qkn[16 + bh]));
    }
}
DI unsigned xcc_id() { return (unsigned)__builtin_amdgcn_s_getreg((3 << 11) | 20) & 0xFu; }
DI void grid_bar(unsigned* ctl, unsigned k, unsigned xcc, unsigned nloc, unsigned nx, int tid) {
    __syncthreads();
    if (tid == 0) {
        const unsigned old = __hip_atomic_fetch_add(ctl + 208 + xcc, 1u, __ATOMIC_RELAXED, __HIP_MEMORY_SCOPE_AGENT);
        if (old + 1 == nloc * k) {
            __builtin_amdgcn_fence(__ATOMIC_RELEASE, "agent");
            __hip_atomic_fetch_add(ctl, 1u, __ATOMIC_RELAXED, __HIP_MEMORY_SCOPE_AGENT);
        }
        while (__hip_atomic_load(ctl, __ATOMIC_RELAXED, __HIP_MEMORY_SCOPE_AGENT) < nx * k) __builtin_amdgcn_s_sleep(1);
        __builtin_amdgcn_fence(__ATOMIC_ACQUIRE, "agent");
    }
    __syncthreads();
}
DI void launder_all(int& tid, unsigned char*& ws) { asm volatile("" : "+v"(tid)); asm volatile("" : "+s"(ws)); }
__global__ void __launch_bounds__(512, 2) mk_fwd(Args a) {
    extern __shared__ __attribute__((aligned(16))) unsigned char lds_raw[];
    LAS unsigned char* lds = (LAS unsigned char*)lds_raw;
    int tid = threadIdx.x; const int G = gridDim.x, NGW = G * 8;
    unsigned char* ws = a.ws;
#define wave (tid >> 6)
#define lane (tid & 63)
#define gw ((int)blockIdx.x * 8 + wave)
#define HM ((bf16_t*)(ws + WS_HM))
#define PROJ ((bf16_t*)(ws + WS_PROJ))
    int ph = 0;
    unsigned nbar = 0, xcc = 0, nloc = 1, nx = 1;
#if MK_COOP
    cg::grid_group grid = cg::this_grid();
    unsigned* ctl = (unsigned*)(ws + WS_CTR);
    if (a.ph_hi - a.ph_lo > 1) { xcc = xcc_id(); if (tid == 0) __hip_atomic_fetch_add(ctl + 192 + xcc, 1u, __ATOMIC_RELAXED, __HIP_MEMORY_SCOPE_AGENT); }
#define SEAM() do { ++ph; if (a.ph_hi - a.ph_lo > 1) { if (ph == 1) { grid.sync(); nloc = __hip_atomic_load(ctl + 192 + xcc, __ATOMIC_RELAXED, __HIP_MEMORY_SCOPE_AGENT); nx = 0; \
            for (int j = 0; j < 16; ++j) nx += (__hip_atomic_load(ctl + 192 + j, __ATOMIC_RELAXED, __HIP_MEMORY_SCOPE_AGENT) != 0u); } \
        else { ++nbar; grid_bar(ctl, nbar, xcc, nloc, nx, tid); } } else __syncthreads(); } while (0)
#else
#define SEAM() do { ++ph; __syncthreads(); } while (0)
#endif
#define IN() (launder_all(tid, ws), (ph >= a.ph_lo && ph < a.ph_hi))
    if (IN()) { phase_convert(a, lds, gw, NGW, wave, lane, 0, CONV_IL);   phase_x_to_bf16(a.x, HM, (float*)(ws + WS_SSA), gw, NGW, lane); }
    SEAM();
    for (int l = 0; l < DEPTH; ++l) {
        unsigned char* wl = ws + WS_W + (size_t)l * W_LAYER;
        bf16_t* XA = (bf16_t*)a.out;
        if (IN()) { pg8::Gemm g{(l == 0) ? (const bf16_t*)HM : (const bf16_t*)XA, (const bf16_t*)(wl + WO_IN), T, PLD, DM, DM, DM}; pg8::StaticOrder S; S.init(T, PLD, G, blockIdx.x);
            pg8::EpiProj E{PROJ, (float*)(ws + WS_AUX), (const float*)(ws + WS_SSA)}; pg8::gemm_phase(lds, g, S, E, tid); }
        SEAM();
        if (IN()) phase_prep(a, l, lds, tid);
        SEAM();
        if (IN()) {
            { pg8::Gemm g{PROJ + C_MCQ, (const bf16_t*)(wl + WO_UQ), T, 512, 256, PLD, 256}; pg8::StaticOrder S; S.init(T, 512, G, blockIdx.x);
                pg8::EpiScale E{(bf16_t*)(ws + WS_QM), 384, (const float*)(ws + WS_RQ), 384}; pg8::gemm_phase(lds, g, S, E, tid); }
            { pg8::Gemm g{PROJ + C_MCKV, (const bf16_t*)(wl + WO_UKV), T, 512, 128, PLD, 128}; pg8::StaticOrder S; S.init(T, 512, G, blockIdx.x);
                pg8::EpiScale E{(bf16_t*)a.out + (size_t)T * DM, 512, (const float*)(ws + WS_RKV), 512}; pg8::gemm_phase(lds, g, S, E, tid); }
            phase_gla1(a, lds, tid); phase_ssd1(a, lds, tid);
        }
        SEAM();
        if (IN()) phase_attn(a, l, lds, tid);
        SEAM();
        if (IN()) { pg8::Gemm g{HM, (const bf16_t*)(wl + WO_OUT), T, DM, DM, DM, DM}; pg8::StaticOrder S; S.init(T, DM, G, blockIdx.x);
            pg8::EpiResid E{(l == 0) ? (const void*)a.x : (const void*)XA, (l == 0) ? 0 : 1, (bf16_t*)(ws + WS_XB2), (float*)(ws + WS_SSB)}; pg8::gemm_phase(lds, g, S, E, tid); }
        SEAM();
        if (IN()) { pg8::Gemm g{(const bf16_t*)(ws + WS_XB2), (const bf16_t*)(wl + WO_GU), T, 2 * FF, DM, DM, DM}; pg8::StaticOrder S; S.init(T, 2 * FF, G, blockIdx.x);
            pg8::EpiSwiglu E{PROJ, (const float*)(ws + WS_SSB)}; pg8::gemm_phase(lds, g, S, E, tid); }
        SEAM();
        if (IN()) { pg8::Gemm g{PROJ, (const bf16_t*)(wl + WO_D), T, DM, FF, FF, FF}; pg8::StaticOrder S; S.init(T, DM, G, blockIdx.x);
            pg8::EpiResid E{(const void*)(ws + WS_XB2), 1, (l + 1 < DEPTH) ? XA : (bf16_t*)HM, (float*)(ws + WS_SSA)}; pg8::gemm_phase(lds, g, S, E, tid); }
        SEAM();
    }
    if (IN()) phase_final_norm(HM, a.out, a.final_norm, (const float*)(ws + WS_SSA), gw, NGW, lane);
}
constexpr int N_PHASES = 2 + DEPTH * 7;

extern "C" void kernel_launch(void* const* d_in, const int* in_sizes, int n_in, void* d_out, int out_size, void* d_ws, size_t ws_size, hipStream_t stream) {
    static int grid = 0;
    if (grid == 0) {
        int dev = 0, cus = 0, per_cu = 0;
        hipGetDevice(&dev); hipDeviceGetAttribute(&cus, hipDeviceAttributeMultiprocessorCount, dev);
        hipFuncSetAttribute((const void*)mk_fwd, hipFuncAttributeMaxDynamicSharedMemorySize, LDS_BYTES);
        hipOccupancyMaxActiveBlocksPerMultiprocessor(&per_cu, (const void*)mk_fwd, 512, LDS_BYTES);
        if (per_cu < 1) per_cu = 1;
        grid = cus * per_cu; if (grid > 256) grid = 256;
        if (ws_size < WS_END) { fprintf(stderr, "ws too small: %zu < %zu\n", ws_size, (size_t)WS_END); }
        (void)hipGetLastError();
    }
    Args a{};
    a.x = (const float*)d_in[0]; a.pos = (const int*)d_in[1]; a.norm1 = (const float*)d_in[2]; a.w_in = (const float*)d_in[3]; a.fox_b = (const float*)d_in[4];
    a.gla_w2 = (const float*)d_in[5]; a.gla_b = (const float*)d_in[6]; a.gla_on = (const float*)d_in[7]; a.mla_qn = (const float*)d_in[8]; a.mla_wuq = (const float*)d_in[9];
    a.mla_kvn = (const float*)d_in[10]; a.mla_wukv = (const float*)d_in[11]; a.conv_w = (const float*)d_in[12]; a.conv_b = (const float*)d_in[13]; a.dt_bias = (const float*)d_in[14];
    a.A_log = (const float*)d_in[15]; a.ssm_D = (const float*)d_in[16]; a.ssm_norm = (const float*)d_in[17]; a.w_out = (const float*)d_in[18]; a.norm2 = (const float*)d_in[19];
    a.w_gate = (const float*)d_in[20]; a.w_up = (const float*)d_in[21]; a.w_down = (const float*)d_in[22]; a.final_norm = (const float*)d_in[23];
    a.out = (float*)d_out; a.ws = (unsigned char*)d_ws;
#if MK_COOP
    a.ph_lo = 0; a.ph_hi = N_PHASES;
    (void)hipMemsetAsync((unsigned char*)d_ws + WS_CTR, 0, 1024, stream);
    void* args[] = {&a};
    hipError_t e = hipLaunchCooperativeKernel((const void*)mk_fwd, dim3(grid), dim3(512), args, LDS_BYTES, stream);
    if (e != hipSuccess) fprintf(stderr, "cooperative launch failed: %s (grid %d)\n", hipGetErrorString(e), grid);
#else
    for (int p = 0; p < N_PHASES; ++p) { a.ph_lo = p; a.ph_hi = p + 1; hipLaunchKernelGGL(mk_fwd, dim3(grid), dim3(512), LDS_BYTES, stream, a); }
#endif
}
```
